# Optimizing an MI355X kernel written in HIP

```python
import jax, jax.numpy as jnp
from jax import lax
import numpy as np

D_MODEL = 1024
BATCH = 8
SEQ = 2048
DEPTH = 1
DEC_BATCH = 128
DEC_SEQ = 8
PAST_LEN = 16384
PAGE_SIZE = 128

D_MIX = D_MODEL
D_POOL = D_MIX // 2
D_CONV = D_MIX - D_POOL
POOL_WINDOWS = (2, 4, 8, 16)
N_POOL_GROUPS = len(POOL_WINDOWS)
POOL_GROUP = D_POOL // N_POOL_GROUPS
POOL_HIST = max(POOL_WINDOWS) - 1
CONV_WIDTH = 3
CONV_HIST = CONV_WIDTH - 1
N_CONV_HEADS = 4
D_FF = ((8 * D_MODEL // 3 + 127) // 128) * 128
N_MEM = 256
N_XHEADS = 4
XHEAD_DIM = D_MODEL // N_XHEADS
EPS = 1e-6

kernel_name = "hybrid_pool_conv_macaron_xattn_step"


def _rms(x, g):
    xf = x.astype(jnp.float32)
    y = xf * lax.rsqrt(jnp.mean(xf * xf, axis=-1, keepdims=True) + EPS)
    return (y * g.astype(jnp.float32)).astype(x.dtype)


def _swiglu_half(x, g, w_in, w_out):
    h = _rms(x, g)
    gate, up = jnp.split(h @ w_in, 2, axis=-1)
    return x + 0.5 * ((jax.nn.silu(gate) * up) @ w_out)


def _pool_mix(a, hist, pos0, pool_w, pool_scale):
    b, t, _ = a.shape
    ext = jnp.concatenate([hist, a], axis=1)
    cs = jnp.cumsum(ext.astype(jnp.float32), axis=1)
    cs = jnp.concatenate([jnp.zeros((b, 1, D_POOL), jnp.float32), cs], axis=1)
    end = cs[:, POOL_HIST + 1:]
    pos = pos0 + jnp.arange(t, dtype=jnp.int32)
    af = a.astype(jnp.float32)
    outs = []
    for gi, w in enumerate(POOL_WINDOWS):
        sl = slice(gi * POOL_GROUP, (gi + 1) * POOL_GROUP)
        start = cs[:, POOL_HIST + 1 - w: POOL_HIST + 1 - w + t, sl]
        cnt = jnp.minimum(pos + 1, w).astype(jnp.float32)[None, :, None]
        mean = (end[..., sl] - start) / cnt
        outs.append(mean - af[..., sl])
    d = jnp.stack(outs, axis=2).astype(a.dtype)
    y = jnp.einsum('btgc,gcd->btgd', d, pool_w).reshape(b, t, D_POOL)
    return y * pool_scale, ext[:, -POOL_HIST:]


def _short_conv(u, hist, conv_w):
    t = u.shape[1]
    ext = jnp.concatenate([hist, u], axis=1)
    y = sum(conv_w[k] * ext[:, k:k + t] for k in range(CONV_WIDTH))
    return y, ext[:, -CONV_HIST:]


def _cross_attn(x, g_xq, w_xq, w_xo, mem_k, mem_v):
    b, t, _ = x.shape
    q = (_rms(x, g_xq) @ w_xq).reshape(b, t, N_XHEADS, XHEAD_DIM)
    s = jnp.einsum('bthd,bmhd->bhtm', q.astype(jnp.float32), mem_k.astype(jnp.float32)) * (XHEAD_DIM ** -0.5)
    p = jax.nn.softmax(s, axis=-1).astype(x.dtype)
    o = jnp.einsum('bhtm,bmhd->bthd', p, mem_v).reshape(b, t, N_XHEADS * XHEAD_DIM)
    return x + o @ w_xo


def _layer(x, pos0, pool_hist, conv_hist, mem_k, mem_v, lw):
    (g_ffn1, w_ffn1_in, w_ffn1_out, g_mix, w_mix_in, pool_w, pool_scale, conv_w,
     w_mix_out, g_xq, w_xq, w_xo, g_ffn2, w_ffn2_in, w_ffn2_out) = lw
    x = _swiglu_half(x, g_ffn1, w_ffn1_in, w_ffn1_out)
    z = _rms(x, g_mix) @ w_mix_in
    a = z[..., :D_POOL]
    cb, cc, ch = jnp.split(z[..., D_POOL:], 3, axis=-1)
    p, new_pool = _pool_mix(a, pool_hist, pos0, pool_w, pool_scale)
    yc, new_conv = _short_conv(cc * ch, conv_hist, conv_w)
    x = x + jnp.concatenate([p, cb * yc], axis=-1) @ w_mix_out
    x = _cross_attn(x, g_xq, w_xq, w_xo, mem_k, mem_v)
    x = _swiglu_half(x, g_ffn2, w_ffn2_in, w_ffn2_out)
    return x, new_pool, new_conv


def setup_inputs(seed: int = 0) -> dict:
    key = jax.random.key(seed)
    ks = iter(jax.random.split(key, 40))
    f32 = jnp.float32

    def nrm(shape, fan_in):
        return jax.random.normal(next(ks), shape, f32) * (fan_in ** -0.5)

    def gain(shape):
        return 1.0 + 0.05 * jax.random.normal(next(ks), shape, f32)

    L = DEPTH
    return {
        "x_prompt": jax.random.normal(next(ks), (BATCH, SEQ, D_MODEL), f32),
        "x_sample": jax.random.normal(next(ks), (DEC_BATCH, DEC_SEQ, D_MODEL), f32),
        "mem_prompt": jax.random.normal(next(ks), (BATCH, N_MEM, D_MODEL), f32),
        "state_pool": jax.random.normal(next(ks), (L, DEC_BATCH, POOL_HIST, D_POOL), f32),
        "state_conv": jax.random.normal(next(ks), (L, DEC_BATCH, CONV_HIST, D_CONV), f32),
        "cache_mem_k": jax.random.normal(next(ks), (L, DEC_BATCH, N_MEM, N_XHEADS, XHEAD_DIM), f32),
        "cache_mem_v": jax.random.normal(next(ks), (L, DEC_BATCH, N_MEM, N_XHEADS, XHEAD_DIM), f32),
        "g_ffn1": gain((L, D_MODEL)),
        "w_ffn1_in": nrm((L, D_MODEL, 2 * D_FF), D_MODEL),
        "w_ffn1_out": nrm((L, D_FF, D_MODEL), D_FF),
        "g_mix": gain((L, D_MODEL)),
        "w_mix_in": nrm((L, D_MODEL, D_POOL + 3 * D_CONV), D_MODEL),
        "pool_w": nrm((L, N_POOL_GROUPS, POOL_GROUP, POOL_GROUP), POOL_GROUP),
        "pool_scale": gain((L, D_POOL)),
        "conv_w": nrm((L, CONV_WIDTH, D_CONV), CONV_WIDTH),
        "w_mix_out": nrm((L, D_MIX, D_MODEL), D_MIX),
        "g_xq": gain((L, D_MODEL)),
        "g_mem": gain((L, D_MODEL)),
        "w_xq": nrm((L, D_MODEL, N_XHEADS * XHEAD_DIM), D_MODEL),
        "w_xk": nrm((L, D_MODEL, N_XHEADS * XHEAD_DIM), D_MODEL),
        "w_xv": nrm((L, D_MODEL, N_XHEADS * XHEAD_DIM), D_MODEL),
        "w_xo": nrm((L, N_XHEADS * XHEAD_DIM, D_MODEL), N_XHEADS * XHEAD_DIM),
        "g_ffn2": gain((L, D_MODEL)),
        "w_ffn2_in": nrm((L, D_MODEL, 2 * D_FF), D_MODEL),
        "w_ffn2_out": nrm((L, D_FF, D_MODEL), D_FF),
        "g_final": gain((D_MODEL,)),
    }


def reference(x_prompt, x_sample, mem_prompt, state_pool, state_conv, cache_mem_k, cache_mem_v,
              g_ffn1, w_ffn1_in, w_ffn1_out, g_mix, w_mix_in, pool_w, pool_scale, conv_w, w_mix_out,
              g_xq, g_mem, w_xq, w_xk, w_xv, w_xo, g_ffn2, w_ffn2_in, w_ffn2_out, g_final):
    b_p = x_prompt.shape[0]
    yp, ys = x_prompt, x_sample
    pp, pc, pk, pv, sp, sc = [], [], [], [], [], []
    for l in range(DEPTH):
        lw = (g_ffn1[l], w_ffn1_in[l], w_ffn1_out[l], g_mix[l], w_mix_in[l], pool_w[l], pool_scale[l],
              conv_w[l], w_mix_out[l], g_xq[l], w_xq[l], w_xo[l], g_ffn2[l], w_ffn2_in[l], w_ffn2_out[l])
        mn = _rms(mem_prompt, g_mem[l])
        mk = (mn @ w_xk[l]).reshape(b_p, N_MEM, N_XHEADS, XHEAD_DIM)
        mv = (mn @ w_xv[l]).reshape(b_p, N_MEM, N_XHEADS, XHEAD_DIM)
        zp_pool = jnp.zeros((b_p, POOL_HIST, D_POOL), yp.dtype)
        zp_conv = jnp.zeros((b_p, CONV_HIST, D_CONV), yp.dtype)
        yp, npool, nconv = _layer(yp, 0, zp_pool, zp_conv, mk, mv, lw)
        pp.append(npool); pc.append(nconv); pk.append(mk); pv.append(mv)
        ys, spool, sconv = _layer(ys, PAST_LEN, state_pool[l], state_conv[l], cache_mem_k[l], cache_mem_v[l], lw)
        sp.append(spool); sc.append(sconv)
    y_prompt = _rms(yp, g_final)
    y_sample = _rms(ys, g_final)
    return (y_prompt, y_sample, jnp.stack(pp), jnp.stack(pc), jnp.stack(pk), jnp.stack(pv), jnp.stack(sp), jnp.stack(sc))
```

```cpp
#include <hip/hip_runtime.h>
#include <hip/hip_cooperative_groups.h>
#include <cstdio>
#include <cstdint>
namespace cg = cooperative_groups;

#define LAS __attribute__((address_space(3)))
typedef unsigned short bf16;
typedef short bf16x8 __attribute__((ext_vector_type(8)));
typedef float f32x4 __attribute__((ext_vector_type(4)));
typedef float f32x2 __attribute__((ext_vector_type(2)));
typedef unsigned u32x4 __attribute__((ext_vector_type(4)));
typedef unsigned u32x2 __attribute__((ext_vector_type(2)));

constexpr int D = 1024, SEQ = 2048, NBP = 8, MP = NBP * SEQ, NBS = 128, TS = 8, MS = NBS * TS, M = MP + MS;
constexpr int FF = 2816, NMEM = 256, NH = 4, HD = 256, DPOOL = 512, DCONV = 512, NZ = 2048, MMEM = NBP * NMEM;
constexpr int POOL_HIST = 15, CONV_HIST = 2;
constexpr float EPS = 1e-6f;
constexpr int NWAVES = 8, NTHREADS = 512;
#ifndef PHM
#define PHM 0xffff
#endif

constexpr size_t OUT_Y = 0;
constexpr size_t OUT_POOL_P = (size_t)M * D;
constexpr size_t OUT_CONV_P = OUT_POOL_P + (size_t)NBP * POOL_HIST * DPOOL;
constexpr size_t OUT_K_P = OUT_CONV_P + (size_t)NBP * CONV_HIST * DCONV;
constexpr size_t OUT_V_P = OUT_K_P + (size_t)MMEM * D;
constexpr size_t OUT_POOL_S = OUT_V_P + (size_t)MMEM * D;
constexpr size_t OUT_CONV_S = OUT_POOL_S + (size_t)NBS * POOL_HIST * DPOOL;
constexpr size_t OUT_TOTAL = OUT_CONV_S + (size_t)NBS * CONV_HIST * DCONV;

constexpr size_t MiB = 1u << 20;
constexpr size_t WS_CTL = 0;
constexpr size_t WS_W1IN = 1 * MiB, WS_W1OUT = 12 * MiB, WS_WMIX = 18 * MiB, WS_WEFF = 22 * MiB, WS_WXQ = 24 * MiB, WS_WXKV = 26 * MiB, WS_WXO = 30 * MiB;
constexpr size_t WS_W2IN = 32 * MiB, WS_W2OUT = 43 * MiB, WS_MEMN = 49 * MiB, WS_KB = 53 * MiB, WS_VT = 57 * MiB, WS_SSQ = 61 * MiB;
constexpr size_t WS_XB0 = 64 * MiB, WS_XB1 = 98 * MiB, WS_XB2 = 132 * MiB, WS_XB3 = 166 * MiB, WS_ACT = 200 * MiB, WS_Z = 294 * MiB, WS_A4 = 362 * MiB, WS_QB = 396 * MiB, WS_OB = 430 * MiB, WS_END = 464 * MiB;
constexpr size_t SSQ_STRIDE = 512 * 1024;

constexpr int RING_BYTES = 131072, LDS_T_OFF = RING_BYTES, LDS_MISC_OFF = LDS_T_OFF + 4096, LDS_BYTES = 147456;
constexpr int CW_BAR = 4096;

#define LDS_WAIT() asm volatile("s_waitcnt lgkmcnt(0)" ::: "memory")
#define VM_WAIT() asm volatile("s_waitcnt vmcnt(0)" ::: "memory")

__device__ __forceinline__ unsigned f2bf(float f) { unsigned u = __builtin_bit_cast(unsigned, f); return (u + 0x7fffu + ((u >> 16) & 1u)) >> 16; }
__device__ __forceinline__ unsigned pk2(float lo, float hi) { return f2bf(lo) | (f2bf(hi) << 16); }
__device__ __forceinline__ float bf_lo(unsigned w) { return __builtin_bit_cast(float, w << 16); }
__device__ __forceinline__ float bf_hi(unsigned w) { return __builtin_bit_cast(float, w & 0xffff0000u); }
__device__ __forceinline__ unsigned cvt_pk_bf16(float lo, float hi) { unsigned r; asm volatile("v_cvt_pk_bf16_f32 %0, %1, %2" : "=v"(r) : "v"(lo), "v"(hi)); return r; }
__device__ __forceinline__ float wave_sum(float v) {
#pragma unroll
    for (int o = 1; o < 64; o <<= 1) v += __shfl_xor(v, o);
    return v;
}
__device__ __forceinline__ float silu_f(float g) { return g * __builtin_amdgcn_rcpf(1.0f + __builtin_amdgcn_exp2f(-1.44269504089f * g)); }
__device__ __forceinline__ float row_rs(const float* ssq, int row) { const f32x4 s = *(const f32x4*)(ssq + 4 * (size_t)row); return rsqrtf(((s.x + s.y) + (s.z + s.w)) * (1.0f / D) + EPS); }

namespace pg8 {
constexpr int BM = 256, BK = 64, HALF = 128, HTB = HALF * BK * 2, NXCD = 8, WGM = 8;
__host__ __device__ __forceinline__ int lds_byte(int r, int c) { const int st = (r >> 4) * 2 + (c >> 5), rr = r & 15, cc = c & 31, ob = rr * 64 + cc * 2; return st * 1024 + (ob ^ (((ob >> 9) & 1) << 5)); }
__host__ __device__ __forceinline__ void stage_rc(int b, int& R, int& C) { const int st = b / 1024, sb = b % 1024, swz = sb ^ (((sb >> 9) & 1) << 5); R = (st >> 1) * 16 + swz / 64; C = (st & 1) * 32 + (swz % 64) / 2; }
__host__ __device__ __forceinline__ int perm32(int rho) { const int n = rho >> 4, i = rho & 15; return 8 * (i >> 2) + 4 * n + (i & 3); }

struct Unit { int pm, pn; };
struct Gemm { const bf16* A; const bf16* Bt; int M, N, K; };

struct StaticOrder {
    int nM, nN, nwg, G, c;
    __device__ void init(int M_, int N_, int G_, int c_) { nM = M_ / BM; nN = N_ / BM; nwg = nM * nN; G = G_; c = c_; }
    __device__ bool next(int i, Unit& u) const {
        const long L = (long)i * G + c; if (L >= nwg) return false;
        int wgid = (int)L; { const int q = nwg / NXCD, r = nwg % NXCD, xcd = wgid % NXCD, off = wgid / NXCD; wgid = (xcd < r ? xcd * (q + 1) : r * (q + 1) + (xcd - r) * q) + off; }
        const int nig = WGM * nN, gid = wgid / nig, fm = gid * WGM, gsz = (nM - fm) < WGM ? (nM - fm) : WGM;
        u.pm = fm + ((wgid % nig) % gsz); u.pn = (wgid % nig) / gsz; return true;
    }
    __device__ __forceinline__ void a_ready(const Unit&) const {}
    __device__ __forceinline__ void done(const Unit&) const {}
};

template <class Epi, class Sched, bool ALIGN_EPI = true, bool SP2 = true>
__device__ __forceinline__ void gemm_phase(LAS unsigned char* lds, const Gemm g, const Sched& S, const Epi& E) {
    int tid_ = threadIdx.x; asm volatile("" : "+v"(tid_));
    const int tid = tid_, wid = __builtin_amdgcn_readfirstlane(tid >> 6), lane = tid & 63, wr = wid >> 2, wc = wid & 3, fr = lane & 15, fq = lane >> 4;
    const int K = g.K, nt = K / BK;
    unsigned voffA[2], voffB[2];
#pragma unroll
    for (int i = 0; i < 2; ++i) { int R, C; stage_rc(tid * 16 + i * 8192, R, C); const int Rb = Epi::PERM ? ((R & ~31) + perm32(R & 31)) : R;
        voffA[i] = (unsigned)(R * K + C) * 2u; voffB[i] = (unsigned)(Rb * K + C) * 2u; }
    const size_t kstep = (size_t)(BK * 2);
    const size_t hstep = (size_t)HALF * K * 2;
    const size_t tstep = 2 * hstep;
    const unsigned ldsw = (unsigned)wid * 1024u;
    const int aoff = lds_byte(wr * 64 + fr, fq * 8), boff = lds_byte(wc * 32 + fr, fq * 8);
#define PG8_SA(b, h) (((b) * 2 + (h)) * HTB)
#define PG8_SB(b, h) ((4 + (b) * 2 + (h)) * HTB)
#define PG8_STAGE(bufoff, gbase, voff) do { _Pragma("unroll") for (int _i = 0; _i < 2; ++_i) \
        __builtin_amdgcn_global_load_lds((const unsigned*)((const char*)(gbase) + (voff)[_i]), (LAS unsigned*)(lds + (bufoff) + ldsw + _i * 8192), 16, 0, 0); } while (0)
#define PG8_LDA(dst, b, h) do { _Pragma("unroll") for (int m = 0; m < 4; ++m) _Pragma("unroll") for (int k = 0; k < 2; ++k) dst[m][k] = *(const LAS bf16x8*)(lds + PG8_SA(b, h) + aoff + m * 2048 + k * 1024); } while (0)
#define PG8_LDB(dst, b, h) do { _Pragma("unroll") for (int n = 0; n < 2; ++n) _Pragma("unroll") for (int k = 0; k < 2; ++k) dst[n][k] = *(const LAS bf16x8*)(lds + PG8_SB(b, h) + boff + n * 2048 + k * 1024); } while (0)
#define PG8_MMA(ai, bj, At, Bt) do { __builtin_amdgcn_s_setprio(1); _Pragma("unroll") for (int m = 0; m < 4; ++m) _Pragma("unroll") for (int n = 0; n < 2; ++n) _Pragma("unroll") for (int k = 0; k < 2; ++k) \
        acc[ai][bj][m][n] = __builtin_amdgcn_mfma_f32_16x16x32_bf16(Bt[n][k], At[m][k], acc[ai][bj][m][n], 0, 0, 0); __builtin_amdgcn_s_setprio(0); } while (0)
#define PG8_WAIT_V(n) asm volatile("s_waitcnt vmcnt(" #n ")" ::: "memory")
#define PG8_WAIT_L(n) asm volatile("s_waitcnt lgkmcnt(" #n ")" ::: "memory")
#define PG8_BAR __builtin_amdgcn_s_barrier()
#define PG8_SCHED __builtin_amdgcn_sched_barrier(0)
    Unit cur, nxt; int ui = 0;
    if (!S.next(0, cur)) return;
    f32x4 acc[2][2][4][2];
#pragma unroll
    for (int a = 0; a < 2; ++a)
#pragma unroll
        for (int b = 0; b < 2; ++b)
#pragma unroll
            for (int m = 0; m < 4; ++m)
#pragma unroll
                for (int n = 0; n < 2; ++n) acc[a][b][m][n] = (f32x4){0.f, 0.f, 0.f, 0.f};
    bf16x8 At[4][2], B0[2][2], B1[2][2];
    const char* cA = (const char*)g.A + (size_t)cur.pm * tstep; const char* cB = (const char*)g.Bt + (size_t)cur.pn * tstep;
    S.a_ready(cur);
    if constexpr (SP2) {
        PG8_STAGE(PG8_SB(0, 0), cB, voffB); PG8_STAGE(PG8_SB(0, 1), cB + hstep, voffB); PG8_STAGE(PG8_SA(0, 0), cA, voffA); PG8_STAGE(PG8_SA(0, 1), cA + hstep, voffA);
        if (wr == 1) PG8_BAR;
        PG8_WAIT_V(2); PG8_BAR;
        PG8_STAGE(PG8_SB(1, 0), cB + kstep, voffB); PG8_STAGE(PG8_SA(1, 0), cA + kstep, voffA); PG8_STAGE(PG8_SB(1, 1), cB + hstep + kstep, voffB);
        PG8_WAIT_V(6); PG8_BAR;
    } else {
        PG8_STAGE(PG8_SB(0, 0), cB, voffB); PG8_STAGE(PG8_SA(0, 0), cA, voffA); PG8_STAGE(PG8_SB(0, 1), cB + hstep, voffB); PG8_STAGE(PG8_SA(0, 1), cA + hstep, voffA);
        if (wr == 1) PG8_BAR;
        PG8_WAIT_V(4); PG8_BAR;
        PG8_STAGE(PG8_SB(1, 0), cB + kstep, voffB); PG8_STAGE(PG8_SA(1, 0), cA + kstep, voffA); PG8_STAGE(PG8_SB(1, 1), cB + hstep + kstep, voffB);
        PG8_WAIT_V(6); PG8_BAR;
    }
    for (;;) {
        const bool has_next = S.next(ui + 1, nxt);
        const char* nA = has_next ? (const char*)g.A + (size_t)nxt.pm * tstep : cA; const char* nB = has_next ? (const char*)g.Bt + (size_t)nxt.pn * tstep : cB;
        for (int t = 0; t < nt; t += 2) {
            const bool last = (t == nt - 2);
            const char* a1 = cA + (size_t)(t + 1) * kstep;
            const char* a2 = last ? nA : cA + (size_t)(t + 2) * kstep; const char* b2 = last ? nB : cB + (size_t)(t + 2) * kstep;
            const char* a3 = a2 + kstep; const char* b3 = b2 + kstep;
            if (last && has_next) S.a_ready(nxt);
            if constexpr (SP2) {
            PG8_LDB(B0, 0, 0); PG8_LDB(B1, 0, 1); PG8_SCHED; PG8_LDA(At, 0, 0); PG8_STAGE(PG8_SA(1, 1), a1 + hstep, voffA);
            PG8_WAIT_V(8); PG8_WAIT_L(0); PG8_BAR; PG8_MMA(0, 0, At, B0); PG8_MMA(0, 1, At, B1); PG8_BAR; PG8_SCHED;
            PG8_LDA(At, 0, 1); PG8_STAGE(PG8_SB(0, 0), b2, voffB); PG8_STAGE(PG8_SB(0, 1), b2 + hstep, voffB); PG8_STAGE(PG8_SA(0, 0), a2, voffA);
            PG8_WAIT_V(8); PG8_WAIT_L(0); PG8_BAR; PG8_MMA(1, 0, At, B0); PG8_MMA(1, 1, At, B1); PG8_BAR; PG8_SCHED;
            PG8_LDB(B0, 1, 0); PG8_LDB(B1, 1, 1); PG8_SCHED; PG8_LDA(At, 1, 0); PG8_STAGE(PG8_SA(0, 1), a2 + hstep, voffA);
            PG8_WAIT_V(8); PG8_WAIT_L(0); PG8_BAR; PG8_MMA(0, 0, At, B0); PG8_MMA(0, 1, At, B1); PG8_BAR; PG8_SCHED;
            PG8_LDA(At, 1, 1); PG8_STAGE(PG8_SB(1, 0), b3, voffB); PG8_STAGE(PG8_SB(1, 1), b3 + hstep, voffB); PG8_STAGE(PG8_SA(1, 0), a3, voffA);
            PG8_WAIT_V(8); PG8_WAIT_L(0); PG8_BAR; PG8_MMA(1, 0, At, B0); PG8_MMA(1, 1, At, B1); PG8_BAR; PG8_SCHED;
            } else {
            PG8_LDB(B0, 0, 0); PG8_SCHED; PG8_LDA(At, 0, 0); PG8_STAGE(PG8_SA(1, 1), a1 + hstep, voffA);
            PG8_WAIT_L(8); PG8_BAR; PG8_WAIT_L(0); PG8_MMA(0, 0, At, B0); PG8_BAR; PG8_SCHED;
            PG8_LDB(B1, 0, 1); PG8_STAGE(PG8_SB(0, 0), b2, voffB);
            PG8_BAR; PG8_WAIT_L(0); PG8_MMA(0, 1, At, B1); PG8_BAR;
            PG8_LDA(At, 0, 1); PG8_STAGE(PG8_SA(0, 0), a2, voffA);
            PG8_BAR; PG8_WAIT_L(0); PG8_MMA(1, 0, At, B0); PG8_BAR; PG8_SCHED;
            PG8_STAGE(PG8_SB(0, 1), b2 + hstep, voffB);
            PG8_WAIT_V(6); PG8_BAR; PG8_MMA(1, 1, At, B1); PG8_BAR;
            PG8_LDB(B0, 1, 0); PG8_SCHED; PG8_LDA(At, 1, 0); PG8_STAGE(PG8_SA(0, 1), a2 + hstep, voffA);
            PG8_WAIT_L(8); PG8_BAR; PG8_WAIT_L(0); PG8_MMA(0, 0, At, B0); PG8_BAR; PG8_SCHED;
            PG8_LDB(B1, 1, 1); PG8_STAGE(PG8_SB(1, 0), b3, voffB);
            PG8_BAR; PG8_WAIT_L(0); PG8_MMA(0, 1, At, B1); PG8_BAR;
            PG8_LDA(At, 1, 1); PG8_STAGE(PG8_SA(1, 0), a3, voffA);
            PG8_BAR; PG8_WAIT_L(0); PG8_MMA(1, 0, At, B0); PG8_BAR; PG8_SCHED;
            PG8_STAGE(PG8_SB(1, 1), b3 + hstep, voffB);
            PG8_WAIT_V(6); PG8_BAR; PG8_MMA(1, 1, At, B1); PG8_BAR;
            }
        }
        if constexpr (ALIGN_EPI) { if (wr == 0) PG8_BAR; }
        E(acc, cur, wr, wc, fr, fq, lds, tid); S.done(cur);
        if (!has_next) break;
#pragma unroll
        for (int a = 0; a < 2; ++a)
#pragma unroll
            for (int b = 0; b < 2; ++b)
#pragma unroll
                for (int m = 0; m < 4; ++m)
#pragma unroll
                    for (int n = 0; n < 2; ++n) acc[a][b][m][n] = (f32x4){0.f, 0.f, 0.f, 0.f};
        cur = nxt; cA = nA; cB = nB; ++ui;
        if constexpr (ALIGN_EPI) { if (wr == 1) PG8_BAR; }
    }
    PG8_WAIT_V(0);
    if constexpr (!ALIGN_EPI) { if (wr == 0) PG8_BAR; }
    PG8_BAR;
#undef PG8_SA
#undef PG8_SB
#undef PG8_STAGE
#undef PG8_LDA
#undef PG8_LDB
#undef PG8_MMA
#undef PG8_WAIT_V
#undef PG8_WAIT_L
#undef PG8_BAR
#undef PG8_SCHED
}
}

typedef f32x4 AccT[2][2][4][2];

struct EpiSwiGLU {
    static constexpr bool PERM = true;
    bf16* O; const float* ssq;
    __device__ __forceinline__ void operator()(const AccT& acc, const pg8::Unit& u, int wr, int wc, int fr, int fq, LAS unsigned char*, int) const {
        const int row0 = u.pm * 256 + wr * 64 + fr, col0 = u.pn * 128 + wc * 32 + 8 * fq;
#pragma unroll
        for (int ai = 0; ai < 2; ++ai)
#pragma unroll
            for (int m = 0; m < 4; ++m) {
                const int row = row0 + ai * 128 + m * 16; const float rs = row_rs(ssq, row);
                float v[8];
#pragma unroll
                for (int n = 0; n < 2; ++n)
#pragma unroll
                    for (int j = 0; j < 4; ++j) { const float gt = acc[ai][0][m][n][j] * rs, up = acc[ai][1][m][n][j] * rs; v[n * 4 + j] = silu_f(gt) * up; }
                u32x4 w; w.x = cvt_pk_bf16(v[0], v[1]); w.y = cvt_pk_bf16(v[2], v[3]); w.z = cvt_pk_bf16(v[4], v[5]); w.w = cvt_pk_bf16(v[6], v[7]);
                *(u32x4*)(O + (size_t)row * FF + col0) = w;
            }
    }
};

struct EpiScaleBf16 {
    static constexpr bool PERM = true;
    bf16* O; int ldc; const float* ssq; float cmul;
    __device__ __forceinline__ void operator()(const AccT& acc, const pg8::Unit& u, int wr, int wc, int fr, int fq, LAS unsigned char*, int) const {
        const int row0 = u.pm * 256 + wr * 64 + fr, col0 = u.pn * 256 + wc * 32 + 8 * fq;
#pragma unroll
        for (int ai = 0; ai < 2; ++ai)
#pragma unroll
            for (int m = 0; m < 4; ++m) {
                const int row = row0 + ai * 128 + m * 16; const float rs = row_rs(ssq, row) * cmul;
#pragma unroll
                for (int bj = 0; bj < 2; ++bj) { const f32x4 v0 = acc[ai][bj][m][0] * rs, v1 = acc[ai][bj][m][1] * rs;
                    u32x4 w; w.x = cvt_pk_bf16(v0[0], v0[1]); w.y = cvt_pk_bf16(v0[2], v0[3]); w.z = cvt_pk_bf16(v1[0], v1[1]); w.w = cvt_pk_bf16(v1[2], v1[3]);
                    *(u32x4*)(O + (size_t)row * ldc + col0 + bj * 128) = w; }
            }
    }
};

struct EpiRes {
    static constexpr bool PERM = true;
    const float* resP; const float* resS;
    float* out; bf16* xb; float* ssq; float alpha;
    __device__ __forceinline__ void operator()(const AccT& acc, const pg8::Unit& u, int wr, int wc, int fr, int fq, LAS unsigned char* lds, int tid) const {
        const float* res = (u.pm < 64) ? resP + (size_t)u.pm * 256 * D : resS + (size_t)(u.pm - 64) * 256 * D;
        float* outp = out + (size_t)u.pm * 256 * D;
        const int col0 = u.pn * 256 + wc * 32 + 8 * fq;
        LAS float* T = (LAS float*)(lds + LDS_T_OFF);
#pragma unroll
        for (int ai = 0; ai < 2; ++ai)
#pragma unroll
            for (int m = 0; m < 4; ++m) {
                const int r = ai * 128 + wr * 64 + m * 16 + fr; const size_t off = (size_t)r * D + col0;
                f32x4 x[2][2]; float s = 0.f;
#pragma unroll
                for (int bj = 0; bj < 2; ++bj)
#pragma unroll
                    for (int n = 0; n < 2; ++n) { const f32x4 bs = *(const f32x4*)(res + off + bj * 128 + n * 4); const f32x4 v = bs + acc[ai][bj][m][n] * alpha; x[bj][n] = v;
                        s += (v[0] * v[0] + v[1] * v[1]) + (v[2] * v[2] + v[3] * v[3]); }
#pragma unroll
                for (int bj = 0; bj < 2; ++bj) {
                    *(f32x4*)(outp + off + bj * 128) = x[bj][0]; *(f32x4*)(outp + off + bj * 128 + 4) = x[bj][1];
                    if (xb) { u32x4 w; w.x = cvt_pk_bf16(x[bj][0][0], x[bj][0][1]); w.y = cvt_pk_bf16(x[bj][0][2], x[bj][0][3]); w.z = cvt_pk_bf16(x[bj][1][0], x[bj][1][1]); w.w = cvt_pk_bf16(x[bj][1][2], x[bj][1][3]);
                        *(u32x4*)(xb + (size_t)u.pm * 256 * D + off + bj * 128) = w; }
                }
                if (ssq) { s += __shfl_xor(s, 16); s += __shfl_xor(s, 32); if (fq == 0) T[r * 4 + wc] = s; }
                asm volatile("" ::: "memory");
            }
        if (ssq) {
            LDS_WAIT(); __builtin_amdgcn_s_barrier(); asm volatile("" ::: "memory");
            if (tid < 256) { const f32x4 t = *(const LAS f32x4*)(T + tid * 4); ssq[(size_t)(u.pm * 256 + tid) * 4 + u.pn] = (t.x + t.y) + (t.z + t.w); }
        }
    }
};

struct EpiKV {
    static constexpr bool PERM = true;
    float* outK; float* outV; bf16* KB; bf16* VT; const float* ssq;
    __device__ __forceinline__ void operator()(const AccT& acc, const pg8::Unit& u, int wr, int wc, int fr, int fq, LAS unsigned char*, int) const {
        const bool isV = u.pn >= 4; const int hh = u.pn & 3;
        float* o32 = isV ? outV : outK;
        const int col0 = hh * 256 + wc * 32 + 8 * fq;
#pragma unroll
        for (int ai = 0; ai < 2; ++ai)
#pragma unroll
            for (int m = 0; m < 4; ++m) {
                const int key = ai * 128 + wr * 64 + m * 16 + fr, row = u.pm * 256 + key; const float rs = row_rs(ssq, row);
#pragma unroll
                for (int bj = 0; bj < 2; ++bj) { const f32x4 v0 = acc[ai][bj][m][0] * rs, v1 = acc[ai][bj][m][1] * rs;
                    float* op = o32 + (size_t)row * D + col0 + bj * 128; *(f32x4*)op = v0; *(f32x4*)(op + 4) = v1;
                    if (!isV) { u32x4 w; w.x = cvt_pk_bf16(v0[0], v0[1]); w.y = cvt_pk_bf16(v0[2], v0[3]); w.z = cvt_pk_bf16(v1[0], v1[1]); w.w = cvt_pk_bf16(v1[2], v1[3]);
                        *(u32x4*)(KB + (size_t)row * D + col0 + bj * 128) = w; }
                    else { const int d0 = wc * 32 + 8 * fq + bj * 128; bf16* vp = VT + ((size_t)(u.pm * 4 + hh) * 256 + d0) * 256 + key;
#pragma unroll
                        for (int j = 0; j < 4; ++j) { vp[(size_t)j * 256] = (bf16)f2bf(v0[j]); vp[(size_t)(4 + j) * 256] = (bf16)f2bf(v1[j]); } }
                }
            }
    }
};


#define XB_TMO      128
#define XB_XCNT(j)  (256  + 64 * (j))
#define XB_XSUB(j)  (1280 + 64 * (j))
#define XB_XGEN(j)  (2304 + 64 * (j))
#define XB_TOP      3328
#define XB_TOPGEN   3392
#define XCD_BAR_WORDS 3456
#define XB_SPIN_CAP (1u << 22)
__device__ __forceinline__ unsigned xb_ld(unsigned* p)              { return __hip_atomic_load(p, __ATOMIC_RELAXED, __HIP_MEMORY_SCOPE_AGENT); }
__device__ __forceinline__ unsigned xb_add(unsigned* p, unsigned v) { return __hip_atomic_fetch_add(p, v, __ATOMIC_RELAXED, __HIP_MEMORY_SCOPE_AGENT); }
__device__ __forceinline__ unsigned xb_xcc_id() { return (unsigned)__builtin_amdgcn_s_getreg((3 << 11) | 20) & 0xFu; }
#define XB_SPIN(cond, bar) do { unsigned _sp = 0; while (cond) { __builtin_amdgcn_s_sleep(1); \
    if ((++_sp & 255u) == 0u) { if (xb_ld(&(bar)[XB_TMO])) break; if (_sp > XB_SPIN_CAP) { atomicAdd(&(bar)[XB_TMO], 1u); break; } } } } while (0)
struct XcdBarrier { unsigned* bar; unsigned x; volatile LAS unsigned* st; };
__device__ __forceinline__ XcdBarrier xcd_barrier_post(unsigned* bar, volatile LAS unsigned* st) {
    XcdBarrier b; b.bar = bar; b.x = xb_xcc_id(); b.st = st;
    if (threadIdx.x == 0) (void)xb_add(&bar[XB_XCNT(b.x)], 1u);
    return b;
}
__device__ __forceinline__ void xcd_barrier_complete(unsigned* bar, unsigned x, unsigned& nloc, unsigned& nx) {
    const unsigned G = gridDim.x * gridDim.y * gridDim.z;
    unsigned sum, cnt, mine, sp = 0u;
    for (;;) {
        sum = 0u; cnt = 0u; mine = 0u;
#pragma unroll
        for (unsigned j = 0; j < 16; ++j) { const unsigned c = xb_ld(&bar[XB_XCNT(j)]); sum += c; cnt += (c > 0u) ? 1u : 0u; mine = (j == x) ? c : mine; }
        if (sum == G) break;
        __builtin_amdgcn_s_sleep(1);
        if ((++sp & 255u) == 0u) { if (xb_ld(&bar[XB_TMO])) break; if (sp > XB_SPIN_CAP) { atomicAdd(&bar[XB_TMO], 1u); break; } }
    }
    nloc = mine > 0u ? mine : 1u; nx = cnt > 0u ? cnt : 1u;
}
__device__ __forceinline__ void xcd_barrier(const XcdBarrier& b) {
    asm volatile("s_waitcnt vmcnt(0)" ::: "memory");
    __syncthreads();
    if (threadIdx.x == 0) {
        unsigned* bar = b.bar;
        __builtin_amdgcn_s_waitcnt(0);
        unsigned nloc = b.st[0], nx = b.st[1];
        if (nloc == 0u) { xcd_barrier_complete(bar, b.x, nloc, nx); b.st[0] = nloc; b.st[1] = nx; }
        const unsigned old = xb_add(&bar[XB_XSUB(b.x)], 1u);
        const unsigned gen = old / nloc;
        if (old + 1u == (gen + 1u) * nloc) {
            __builtin_amdgcn_fence(__ATOMIC_RELEASE, "agent");
            asm volatile("s_waitcnt vmcnt(0)" ::: "memory");
            const unsigned og = xb_add(&bar[XB_TOP], 1u);
            const unsigned tg = og / nx;
            if (og + 1u == (tg + 1u) * nx) xb_add(&bar[XB_TOPGEN], 1u);
            else XB_SPIN(xb_ld(&bar[XB_TOPGEN]) == tg, bar);
            __builtin_amdgcn_fence(__ATOMIC_ACQUIRE, "agent");
            xb_add(&bar[XB_XGEN(b.x)], 1u);
            asm volatile("s_waitcnt vmcnt(0)" ::: "memory");
        } else {
            XB_SPIN(xb_ld(&bar[XB_XGEN(b.x)]) == gen, bar);
            __builtin_amdgcn_fence(__ATOMIC_ACQUIRE, "agent");
            asm volatile("s_waitcnt vmcnt(0)" ::: "memory");
        }
    }
    __syncthreads();
}

struct Args {
    const float* in[26];
    float* out; unsigned char* ws;
};

struct Ctx { int tid, lane, wave, gw, NGW, G; LAS unsigned char* lds; };

__device__ __forceinline__ void p0_transpose_item(const float* W, int K, int N, bf16* WT, int ldk, const float* gk, float cmul, int mode, int row_off, int kbeg, LAS float* scr, int item, int lane) {
    const int nblk = N / 32, kb = item / nblk, nb = item % nblk, k0 = kbeg + 64 * kb, n0 = 32 * nb;
#pragma unroll 8
    for (int i = 0; i < 32; ++i) { const int kk = 2 * i + (lane >> 5); const float sc = (gk ? gk[k0 + kk] : 1.0f) * cmul; scr[kk * 33 + (lane & 31)] = W[(size_t)(k0 + kk) * N + n0 + (lane & 31)] * sc; }
    LDS_WAIT();
    const int c = lane & 7;
#pragma unroll
    for (int j = 0; j < 4; ++j) { const int n = (lane >> 3) + 8 * j; const LAS float* s = scr + (8 * c) * 33 + n;
        u32x4 o; o.x = pk2(s[0 * 33], s[1 * 33]); o.y = pk2(s[2 * 33], s[3 * 33]); o.z = pk2(s[4 * 33], s[5 * 33]); o.w = pk2(s[6 * 33], s[7 * 33]);
        const int ns = n0 + n; int dr;
        if (mode == 1) { const int half = ns >= FF ? 1 : 0, cc = ns - half * FF; dr = 256 * (cc >> 7) + 128 * half + (cc & 127); } else dr = row_off + ns;
        *(u32x4*)(WT + (size_t)dr * ldk + k0 + 8 * c) = o; }
    LDS_WAIT();
}
__device__ __forceinline__ void p0_weff_item(const float* pool_w, const float* pool_scale, const float* Wmo, bf16* WT, int item, int lane) {
    const int kb = item >> 5, nb = item & 31, k = kb * 64 + lane, g = k >> 7, n0 = nb * 32;
    const float* pw = pool_w + (size_t)k * 128;
    float acc[32];
#pragma unroll
    for (int n = 0; n < 32; ++n) acc[n] = 0.f;
    for (int dd = 0; dd < 128; dd += 4) {
        const f32x4 p4 = *(const f32x4*)(pw + dd);
#pragma unroll
        for (int e = 0; e < 4; ++e) {
            const float pv = p4[e] * pool_scale[g * 128 + dd + e];
            const f32x4* wrow = (const f32x4*)(Wmo + (size_t)(g * 128 + dd + e) * D + n0);
#pragma unroll
            for (int n4 = 0; n4 < 8; ++n4) { const f32x4 w4 = wrow[n4]; acc[4 * n4] += pv * w4.x; acc[4 * n4 + 1] += pv * w4.y; acc[4 * n4 + 2] += pv * w4.z; acc[4 * n4 + 3] += pv * w4.w; }
        }
    }
#pragma unroll
    for (int n = 0; n < 32; ++n) WT[(size_t)(n0 + n) * D + k] = (bf16)f2bf(acc[n]);
}
__device__ __forceinline__ void p0_row(const float* xrow, bf16* orow, float* ssq4, int lane) {
    const f32x4* xr = (const f32x4*)xrow + lane;
    f32x4 v[4]; float s = 0.f;
#pragma unroll
    for (int j = 0; j < 4; ++j) { v[j] = xr[64 * j]; s += (v[j].x * v[j].x + v[j].y * v[j].y) + (v[j].z * v[j].z + v[j].w * v[j].w); }
    s = wave_sum(s);
    u32x2* o8 = (u32x2*)orow + lane;
#pragma unroll
    for (int j = 0; j < 4; ++j) { u32x2 w; w.x = pk2(v[j].x, v[j].y); w.y = pk2(v[j].z, v[j].w); o8[64 * j] = w; }
    if (lane == 0) *(f32x4*)ssq4 = (f32x4){s, 0.f, 0.f, 0.f};
}

__device__ __forceinline__ void p0_prologue(const Ctx& C, const Args& A) {
    unsigned char* ws = A.ws;
    LAS float* scr = (LAS float*)(C.lds + C.wave * 16384);
    constexpr int I_1IN = (D / 64) * (2 * FF / 32), I_1OUT = (FF / 64) * (D / 32), I_MIX = (D / 64) * (NZ / 32), I_MO = (512 / 64) * (D / 32), I_SQ = (D / 64) * (D / 32), I_EFF = 8 * 32;
    constexpr int NITEMS = 2 * I_1IN + 2 * I_1OUT + I_MIX + I_MO + 4 * I_SQ + I_EFF;
    for (int it = C.gw; it < NITEMS; it += C.NGW) {
        int r = it;
        if (r < I_EFF) { p0_weff_item(A.in[12], A.in[13], A.in[15], (bf16*)(ws + WS_WEFF), r, C.lane); continue; } r -= I_EFF;
        if (r < I_1IN) { p0_transpose_item(A.in[8], D, 2 * FF, (bf16*)(ws + WS_W1IN), D, A.in[7], 1.f, 1, 0, 0, scr, r, C.lane); continue; } r -= I_1IN;
        if (r < I_1IN) { p0_transpose_item(A.in[23], D, 2 * FF, (bf16*)(ws + WS_W2IN), D, A.in[22], 1.f, 1, 0, 0, scr, r, C.lane); continue; } r -= I_1IN;
        if (r < I_1OUT) { p0_transpose_item(A.in[9], FF, D, (bf16*)(ws + WS_W1OUT), FF, nullptr, 1.f, 0, 0, 0, scr, r, C.lane); continue; } r -= I_1OUT;
        if (r < I_1OUT) { p0_transpose_item(A.in[24], FF, D, (bf16*)(ws + WS_W2OUT), FF, nullptr, 1.f, 0, 0, 0, scr, r, C.lane); continue; } r -= I_1OUT;
        if (r < I_MIX) { p0_transpose_item(A.in[11], D, NZ, (bf16*)(ws + WS_WMIX), D, A.in[10], 1.f, 0, 0, 0, scr, r, C.lane); continue; } r -= I_MIX;
        if (r < I_MO) { p0_transpose_item(A.in[15], D, D, (bf16*)(ws + WS_WEFF), D, nullptr, 1.f, 0, 0, 512, scr, r, C.lane); continue; } r -= I_MO;
        if (r < I_SQ) { p0_transpose_item(A.in[18], D, D, (bf16*)(ws + WS_WXQ), D, A.in[16], 0.0625f, 0, 0, 0, scr, r, C.lane); continue; } r -= I_SQ;
        if (r < I_SQ) { p0_transpose_item(A.in[19], D, D, (bf16*)(ws + WS_WXKV), D, A.in[17], 1.f, 0, 0, 0, scr, r, C.lane); continue; } r -= I_SQ;
        if (r < I_SQ) { p0_transpose_item(A.in[20], D, D, (bf16*)(ws + WS_WXKV), D, A.in[17], 1.f, 0, D, 0, scr, r, C.lane); continue; } r -= I_SQ;
        p0_transpose_item(A.in[21], D, D, (bf16*)(ws + WS_WXO), D, nullptr, 1.f, 0, 0, 0, scr, r, C.lane);
    }
    bf16* XB0 = (bf16*)(ws + WS_XB0); float* SSQ0 = (float*)(ws + WS_SSQ);
    for (int m = C.gw; m < M; m += C.NGW) { const float* xr = (m < MP) ? A.in[0] + (size_t)m * D : A.in[1] + (size_t)(m - MP) * D; p0_row(xr, XB0 + (size_t)m * D, SSQ0 + 4 * (size_t)m, C.lane); }
    bf16* MEMN = (bf16*)(ws + WS_MEMN); float* SSQM = (float*)(ws + WS_SSQ + 4 * SSQ_STRIDE);
    for (int m = C.gw; m < MMEM; m += C.NGW) p0_row(A.in[2] + (size_t)m * D, MEMN + (size_t)m * D, SSQM + 4 * (size_t)m, C.lane);
}

__device__ __forceinline__ void unpack8(const u32x4 w, float (&f)[8]) { f[0] = bf_lo(w.x); f[1] = bf_hi(w.x); f[2] = bf_lo(w.y); f[3] = bf_hi(w.y); f[4] = bf_lo(w.z); f[5] = bf_hi(w.z); f[6] = bf_lo(w.w); f[7] = bf_hi(w.w); }
__device__ __forceinline__ void mix_row(const Args& A, int row, int lane) {
    const bf16* Z = (const bf16*)(A.ws + WS_Z); bf16* A4 = (bf16*)(A.ws + WS_A4);
    const bool smp = row >= MP; const int b = smp ? (row - MP) >> 3 : row >> 11, t = smp ? (row - MP) & 7 : row & (SEQ - 1);
    const int col = lane * 8;
    {
        const int gi = lane >> 4, w = 2 << gi;
        float sum[8], cur[8];
#pragma unroll
        for (int e = 0; e < 8; ++e) sum[e] = 0.f;
        unpack8(*(const u32x4*)(Z + (size_t)row * NZ + col), cur);
        for (int j = 0; j < 16; ++j) {
            if (j < w) {
                const int tt = t - j; float v[8];
                if (tt >= 0) unpack8(*(const u32x4*)(Z + (size_t)(row - j) * NZ + col), v);
                else if (smp) { const float* hp = A.in[3] + ((size_t)b * POOL_HIST + (POOL_HIST + tt)) * DPOOL + col; const f32x4 h0 = *(const f32x4*)hp, h1 = *(const f32x4*)(hp + 4);
                    v[0] = h0.x; v[1] = h0.y; v[2] = h0.z; v[3] = h0.w; v[4] = h1.x; v[5] = h1.y; v[6] = h1.z; v[7] = h1.w; }
                else {
#pragma unroll
                    for (int e = 0; e < 8; ++e) v[e] = 0.f; }
#pragma unroll
                for (int e = 0; e < 8; ++e) sum[e] += v[e];
            }
        }
        const int cnti = smp ? w : ((t + 1) < w ? (t + 1) : w); const float ic = 1.0f / (float)cnti;
        float d[8];
#pragma unroll
        for (int e = 0; e < 8; ++e) d[e] = sum[e] * ic - cur[e];
        u32x4 o; o.x = pk2(d[0], d[1]); o.y = pk2(d[2], d[3]); o.z = pk2(d[4], d[5]); o.w = pk2(d[6], d[7]);
        *(u32x4*)(A4 + (size_t)row * D + col) = o;
        if (!smp) { if (t >= SEQ - POOL_HIST) { float* op = A.out + OUT_POOL_P + ((size_t)b * POOL_HIST + (t - (SEQ - POOL_HIST))) * DPOOL + col; *(f32x4*)op = (f32x4){cur[0], cur[1], cur[2], cur[3]}; *(f32x4*)(op + 4) = (f32x4){cur[4], cur[5], cur[6], cur[7]}; } }
        else { float* op = A.out + OUT_POOL_S + ((size_t)b * POOL_HIST + (7 + t)) * DPOOL + col; *(f32x4*)op = (f32x4){cur[0], cur[1], cur[2], cur[3]}; *(f32x4*)(op + 4) = (f32x4){cur[4], cur[5], cur[6], cur[7]};
            if (t < 7) { const float* hp = A.in[3] + ((size_t)b * POOL_HIST + (8 + t)) * DPOOL + col; float* o2 = A.out + OUT_POOL_S + ((size_t)b * POOL_HIST + t) * DPOOL + col; *(f32x4*)o2 = *(const f32x4*)hp; *(f32x4*)(o2 + 4) = *(const f32x4*)(hp + 4); } }
    }
    {
        float u[3][8];
#pragma unroll
        for (int k = 0; k < 3; ++k) {
            const int tt = t - 2 + k;
            if (tt >= 0) { float cc[8], ch[8]; const bf16* zp = Z + (size_t)(row - 2 + k) * NZ + col; unpack8(*(const u32x4*)(zp + 1024), cc); unpack8(*(const u32x4*)(zp + 1536), ch);
#pragma unroll
                for (int e = 0; e < 8; ++e) u[k][e] = cc[e] * ch[e]; }
            else if (smp) { const float* hp = A.in[4] + ((size_t)b * CONV_HIST + (CONV_HIST + tt)) * DCONV + col; const f32x4 h0 = *(const f32x4*)hp, h1 = *(const f32x4*)(hp + 4);
                u[k][0] = h0.x; u[k][1] = h0.y; u[k][2] = h0.z; u[k][3] = h0.w; u[k][4] = h1.x; u[k][5] = h1.y; u[k][6] = h1.z; u[k][7] = h1.w; }
            else {
#pragma unroll
                for (int e = 0; e < 8; ++e) u[k][e] = 0.f; }
        }
        float cb[8]; unpack8(*(const u32x4*)(Z + (size_t)row * NZ + 512 + col), cb);
        const float* cw = A.in[14] + col; float y[8];
#pragma unroll
        for (int e = 0; e < 8; ++e) y[e] = cb[e] * (cw[e] * u[0][e] + cw[DCONV + e] * u[1][e] + cw[2 * DCONV + e] * u[2][e]);
        u32x4 o; o.x = pk2(y[0], y[1]); o.y = pk2(y[2], y[3]); o.z = pk2(y[4], y[5]); o.w = pk2(y[6], y[7]);
        *(u32x4*)(A4 + (size_t)row * D + 512 + col) = o;
        const int tl = smp ? TS : SEQ;
        if (t >= tl - CONV_HIST) { float* op = A.out + (smp ? OUT_CONV_S : OUT_CONV_P) + ((size_t)b * CONV_HIST + (t - (tl - CONV_HIST))) * DCONV + col;
            *(f32x4*)op = (f32x4){u[2][0], u[2][1], u[2][2], u[2][3]}; *(f32x4*)(op + 4) = (f32x4){u[2][4], u[2][5], u[2][6], u[2][7]}; }
    }
}

#define MFMA16(a, b, c) __builtin_amdgcn_mfma_f32_16x16x32_bf16(a, b, c, 0, 0, 0)
__device__ __forceinline__ void attn_prompt_unit(const bf16* Q, const bf16* KB, const bf16* VT, bf16* O, int b, int h, int qt, int lane) {
    const int c = lane & 15, g = lane >> 4;
    const size_t qrow0 = (size_t)b * SEQ + (size_t)qt * 32;
    bf16x8 Bq[2][8];
#pragma unroll
    for (int qb = 0; qb < 2; ++qb)
#pragma unroll
        for (int ks = 0; ks < 8; ++ks) Bq[qb][ks] = *(const bf16x8*)(Q + (qrow0 + qb * 16 + c) * D + h * HD + ks * 32 + 8 * g);
    f32x4 S[2][16];
#pragma unroll
    for (int qb = 0; qb < 2; ++qb)
#pragma unroll
        for (int kb = 0; kb < 16; ++kb) S[qb][kb] = (f32x4){0.f, 0.f, 0.f, 0.f};
    const bf16* Kp = KB + ((size_t)b * NMEM + c) * D + h * HD + 8 * g;
#pragma unroll
    for (int kb = 0; kb < 16; ++kb)
#pragma unroll
        for (int ks = 0; ks < 8; ++ks) { const bf16x8 Ak = *(const bf16x8*)(Kp + (size_t)kb * 16 * D + ks * 32);
            S[0][kb] = MFMA16(Ak, Bq[0][ks], S[0][kb]); S[1][kb] = MFMA16(Ak, Bq[1][ks], S[1][kb]); }
    float inv[2]; bf16x8 Pa[2][8];
#pragma unroll
    for (int qb = 0; qb < 2; ++qb) {
        float mx = -3.0e38f;
#pragma unroll
        for (int kb = 0; kb < 16; ++kb)
#pragma unroll
            for (int j = 0; j < 4; ++j) mx = fmaxf(mx, S[qb][kb][j]);
        mx = fmaxf(mx, __shfl_xor(mx, 16)); mx = fmaxf(mx, __shfl_xor(mx, 32));
        float sm = 0.f;
#pragma unroll
        for (int kb = 0; kb < 16; ++kb)
#pragma unroll
            for (int j = 0; j < 4; ++j) { const float p = __builtin_amdgcn_exp2f((S[qb][kb][j] - mx) * 1.44269504089f); S[qb][kb][j] = p; sm += p; }
        sm += __shfl_xor(sm, 16); sm += __shfl_xor(sm, 32);
        inv[qb] = 1.0f / sm;
#pragma unroll
        for (int s = 0; s < 8; ++s) { u32x4 w; w.x = cvt_pk_bf16(S[qb][2 * s][0], S[qb][2 * s][1]); w.y = cvt_pk_bf16(S[qb][2 * s][2], S[qb][2 * s][3]);
            w.z = cvt_pk_bf16(S[qb][2 * s + 1][0], S[qb][2 * s + 1][1]); w.w = cvt_pk_bf16(S[qb][2 * s + 1][2], S[qb][2 * s + 1][3]); Pa[qb][s] = __builtin_bit_cast(bf16x8, w); }
    }
    const bf16* Vp = VT + ((size_t)(b * NH + h) * HD + c) * NMEM + 4 * g;
#pragma unroll 2
    for (int db = 0; db < 16; ++db) {
        f32x4 o0 = (f32x4){0.f, 0.f, 0.f, 0.f}, o1 = o0;
#pragma unroll
        for (int s = 0; s < 8; ++s) { const u32x2 lo = *(const u32x2*)(Vp + (size_t)db * 16 * NMEM + s * 32), hi = *(const u32x2*)(Vp + (size_t)db * 16 * NMEM + s * 32 + 16);
            const u32x4 w = (u32x4){lo.x, lo.y, hi.x, hi.y}; const bf16x8 Av = __builtin_bit_cast(bf16x8, w);
            o0 = MFMA16(Av, Pa[0][s], o0); o1 = MFMA16(Av, Pa[1][s], o1); }
        o0 = o0 * inv[0]; o1 = o1 * inv[1];
        u32x2 w0, w1; w0.x = cvt_pk_bf16(o0[0], o0[1]); w0.y = cvt_pk_bf16(o0[2], o0[3]); w1.x = cvt_pk_bf16(o1[0], o1[1]); w1.y = cvt_pk_bf16(o1[2], o1[3]);
        *(u32x2*)(O + (qrow0 + c) * D + h * HD + db * 16 + 4 * g) = w0; *(u32x2*)(O + (qrow0 + 16 + c) * D + h * HD + db * 16 + 4 * g) = w1;
    }
}
__device__ __forceinline__ void attn_sample_unit(const bf16* Q, const float* K32, const float* V32, bf16* O, int b, int h, LAS float* pl, int lane) {
    const int c = lane & 15, g = lane >> 4, cq = c & 7;
    const size_t qrow = (size_t)MP + (size_t)b * TS + cq;
    bf16x8 Bq[8];
#pragma unroll
    for (int ks = 0; ks < 8; ++ks) Bq[ks] = *(const bf16x8*)(Q + qrow * D + h * HD + ks * 32 + 8 * g);
    f32x4 S[16];
#pragma unroll
    for (int kb = 0; kb < 16; ++kb) S[kb] = (f32x4){0.f, 0.f, 0.f, 0.f};
    const float* Kp = K32 + (((size_t)b * NMEM + c) * NH + h) * HD + 8 * g;
#pragma unroll
    for (int kb = 0; kb < 16; ++kb)
#pragma unroll
        for (int ks = 0; ks < 8; ++ks) { const float* kp = Kp + (size_t)kb * 16 * NH * HD + ks * 32; const f32x4 k0 = *(const f32x4*)kp, k1 = *(const f32x4*)(kp + 4);
            u32x4 w; w.x = cvt_pk_bf16(k0[0], k0[1]); w.y = cvt_pk_bf16(k0[2], k0[3]); w.z = cvt_pk_bf16(k1[0], k1[1]); w.w = cvt_pk_bf16(k1[2], k1[3]);
            S[kb] = MFMA16(__builtin_bit_cast(bf16x8, w), Bq[ks], S[kb]); }
    float mx = -3.0e38f;
#pragma unroll
    for (int kb = 0; kb < 16; ++kb)
#pragma unroll
        for (int j = 0; j < 4; ++j) mx = fmaxf(mx, S[kb][j]);
    mx = fmaxf(mx, __shfl_xor(mx, 16)); mx = fmaxf(mx, __shfl_xor(mx, 32));
    float sm = 0.f;
#pragma unroll
    for (int kb = 0; kb < 16; ++kb)
#pragma unroll
        for (int j = 0; j < 4; ++j) { const float p = __builtin_amdgcn_exp2f((S[kb][j] - mx) * 1.44269504089f); S[kb][j] = p; sm += p; }
    sm += __shfl_xor(sm, 16); sm += __shfl_xor(sm, 32);
    if (c < 8) {
#pragma unroll
        for (int kb = 0; kb < 16; ++kb)
#pragma unroll
            for (int j = 0; j < 4; ++j) pl[(kb * 16 + 4 * g + j) * 8 + c] = S[kb][j];
        if (g == 0) pl[2048 + c] = 1.0f / sm;
    }
    LDS_WAIT();
    const float* Vp = V32 + ((size_t)b * NMEM * NH + h) * HD + 4 * lane;
    f32x4 o[8];
#pragma unroll
    for (int q = 0; q < 8; ++q) o[q] = (f32x4){0.f, 0.f, 0.f, 0.f};
#pragma unroll 8
    for (int key = 0; key < NMEM; ++key) {
        const f32x4 v = *(const f32x4*)(Vp + (size_t)key * NH * HD);
        const f32x4 pa = *(const LAS f32x4*)(pl + key * 8), pb = *(const LAS f32x4*)(pl + key * 8 + 4);
        o[0] += v * pa.x; o[1] += v * pa.y; o[2] += v * pa.z; o[3] += v * pa.w; o[4] += v * pb.x; o[5] += v * pb.y; o[6] += v * pb.z; o[7] += v * pb.w;
    }
    const f32x4 ia = *(const LAS f32x4*)(pl + 2048), ib = *(const LAS f32x4*)(pl + 2052);
    const float iv[8] = {ia.x, ia.y, ia.z, ia.w, ib.x, ib.y, ib.z, ib.w};
#pragma unroll
    for (int q = 0; q < 8; ++q) { const f32x4 r = o[q] * iv[q]; u32x2 w; w.x = cvt_pk_bf16(r[0], r[1]); w.y = cvt_pk_bf16(r[2], r[3]);
        *(u32x2*)(O + ((size_t)MP + (size_t)b * TS + q) * D + h * HD + 4 * lane) = w; }
    LDS_WAIT();
}

__device__ __forceinline__ void final_row(float* xrow, const float* gf, int lane) {
    f32x4* xr = (f32x4*)xrow + lane; const f32x4* gr = (const f32x4*)gf + lane;
    f32x4 v[4]; float s = 0.f;
#pragma unroll
    for (int j = 0; j < 4; ++j) { v[j] = xr[64 * j]; s += (v[j].x * v[j].x + v[j].y * v[j].y) + (v[j].z * v[j].z + v[j].w * v[j].w); }
    s = wave_sum(s); const float rs = rsqrtf(s * (1.0f / D) + EPS);
#pragma unroll
    for (int j = 0; j < 4; ++j) xr[64 * j] = v[j] * rs * gr[64 * j];
}

__device__ __forceinline__ int opaque_lane() { int t = threadIdx.x; asm volatile("" : "+v"(t)); return t & 63; }
__global__ void __launch_bounds__(NTHREADS, 2) fwd_megakernel(Args A) {
    extern __shared__ __attribute__((aligned(16))) unsigned char lds_raw[];
    Ctx C; C.tid = threadIdx.x; C.lane = C.tid & 63; C.wave = __builtin_amdgcn_readfirstlane(C.tid >> 6); C.G = gridDim.x;
    C.gw = blockIdx.x * NWAVES + C.wave; C.NGW = C.G * NWAVES; C.lds = (LAS unsigned char*)lds_raw;
    unsigned char* ws = A.ws;
    const int bid = blockIdx.x;
    volatile LAS unsigned* MISC = (volatile LAS unsigned*)(C.lds + LDS_MISC_OFF);
    if (C.tid < 32) MISC[C.tid] = 0u;
    __syncthreads();
    const XcdBarrier xbar = xcd_barrier_post((unsigned*)(ws + WS_CTL) + CW_BAR, MISC + 8);
#define GRID_SYNC() xcd_barrier(xbar)
    bf16* XB0 = (bf16*)(ws + WS_XB0); bf16* XB1 = (bf16*)(ws + WS_XB1); bf16* XB2 = (bf16*)(ws + WS_XB2); bf16* XB3 = (bf16*)(ws + WS_XB3);
    bf16* ACT = (bf16*)(ws + WS_ACT); bf16* ZB = (bf16*)(ws + WS_Z); bf16* A4 = (bf16*)(ws + WS_A4); bf16* QB = (bf16*)(ws + WS_QB); bf16* OB = (bf16*)(ws + WS_OB);
    float* SSQ0 = (float*)(ws + WS_SSQ); float* SSQ1 = (float*)(ws + WS_SSQ + SSQ_STRIDE); float* SSQ2 = (float*)(ws + WS_SSQ + 2 * SSQ_STRIDE); float* SSQ3 = (float*)(ws + WS_SSQ + 3 * SSQ_STRIDE);
    float* SSQM = (float*)(ws + WS_SSQ + 4 * SSQ_STRIDE);
    float* XRES = A.out + OUT_Y;

    if (PHM & 1) p0_prologue(C, A);
    GRID_SYNC();
    if (PHM & 2) { pg8::Gemm g{XB0, (const bf16*)(ws + WS_W1IN), M, 2 * FF, D}; pg8::StaticOrder S; S.init(M, 2 * FF, C.G, bid); EpiSwiGLU E{ACT, SSQ0};
      pg8::gemm_phase<EpiSwiGLU, pg8::StaticOrder>(C.lds, g, S, E); }
    GRID_SYNC();
    if (PHM & 4) { pg8::Gemm g{ACT, (const bf16*)(ws + WS_W1OUT), M, D, FF}; pg8::StaticOrder S; S.init(M, D, C.G, bid); EpiRes E{A.in[0], A.in[1], XRES, XB1, SSQ1, 0.5f};
      pg8::gemm_phase<EpiRes, pg8::StaticOrder>(C.lds, g, S, E); }
    if (PHM & 8) { pg8::Gemm g{(const bf16*)(ws + WS_MEMN), (const bf16*)(ws + WS_WXKV), MMEM, 2 * D, D}; pg8::StaticOrder S; S.init(MMEM, 2 * D, C.G, (bid + 64) % C.G);
      EpiKV E{A.out + OUT_K_P, A.out + OUT_V_P, (bf16*)(ws + WS_KB), (bf16*)(ws + WS_VT), SSQM};
      pg8::gemm_phase<EpiKV, pg8::StaticOrder>(C.lds, g, S, E); }
    GRID_SYNC();
    if (PHM & 16) { pg8::Gemm g{XB1, (const bf16*)(ws + WS_WMIX), M, NZ, D}; pg8::StaticOrder S; S.init(M, NZ, C.G, bid); EpiScaleBf16 E{ZB, NZ, SSQ1, 1.0f};
      pg8::gemm_phase<EpiScaleBf16, pg8::StaticOrder>(C.lds, g, S, E); }
    GRID_SYNC();
    if (PHM & 32) { const int ln = opaque_lane(); for (int r = C.gw; r < M; r += C.NGW) mix_row(A, r, ln); }
    GRID_SYNC();
    if (PHM & 64) { pg8::Gemm g{A4, (const bf16*)(ws + WS_WEFF), M, D, D}; pg8::StaticOrder S; S.init(M, D, C.G, bid); EpiRes E{XRES, XRES + (size_t)MP * D, XRES, XB2, SSQ2, 1.0f};
      pg8::gemm_phase<EpiRes, pg8::StaticOrder>(C.lds, g, S, E); }
    GRID_SYNC();
    if (PHM & 128) { pg8::Gemm g{XB2, (const bf16*)(ws + WS_WXQ), M, D, D}; pg8::StaticOrder S; S.init(M, D, C.G, bid); EpiScaleBf16 E{QB, D, SSQ2, 1.0f};
      pg8::gemm_phase<EpiScaleBf16, pg8::StaticOrder>(C.lds, g, S, E); }
    GRID_SYNC();
    if (PHM & 256) { LAS float* pl = (LAS float*)(C.lds + C.wave * 16384); const int ln = opaque_lane();
      for (int u = C.gw; u < NBS * NH; u += C.NGW) attn_sample_unit(QB, A.in[5], A.in[6], OB, u >> 2, u & 3, pl, ln);
      for (int u = C.gw; u < NBP * NH * (SEQ / 32); u += C.NGW) { const int qt = u & 63, bh = u >> 6; attn_prompt_unit(QB, (const bf16*)(ws + WS_KB), (const bf16*)(ws + WS_VT), OB, bh >> 2, bh & 3, qt, ln); } }
    GRID_SYNC();
    if (PHM & 512) { pg8::Gemm g{OB, (const bf16*)(ws + WS_WXO), M, D, D}; pg8::StaticOrder S; S.init(M, D, C.G, bid); EpiRes E{XRES, XRES + (size_t)MP * D, XRES, XB3, SSQ3, 1.0f};
      pg8::gemm_phase<EpiRes, pg8::StaticOrder>(C.lds, g, S, E); }
    GRID_SYNC();
    if (PHM & 1024) { pg8::Gemm g{XB3, (const bf16*)(ws + WS_W2IN), M, 2 * FF, D}; pg8::StaticOrder S; S.init(M, 2 * FF, C.G, bid); EpiSwiGLU E{ACT, SSQ3};
      pg8::gemm_phase<EpiSwiGLU, pg8::StaticOrder>(C.lds, g, S, E); }
    GRID_SYNC();
    if (PHM & 2048) { pg8::Gemm g{ACT, (const bf16*)(ws + WS_W2OUT), M, D, FF}; pg8::StaticOrder S; S.init(M, D, C.G, bid); EpiRes E{XRES, XRES + (size_t)MP * D, XRES, nullptr, nullptr, 0.5f};
      pg8::gemm_phase<EpiRes, pg8::StaticOrder>(C.lds, g, S, E); }
    GRID_SYNC();
    if (PHM & 4096) { const int ln = opaque_lane(); for (int r = C.gw; r < M; r += C.NGW) final_row(XRES + (size_t)r * D, A.in[25], ln); }
}

extern "C" void kernel_launch(void* const* d_in, const int* in_sizes, int n_in, void* d_out, int out_size, void* d_ws, size_t ws_size, hipStream_t stream) {
    static int grid_blocks = 0;
    if (grid_blocks == 0) {
        if (n_in != 26 || (size_t)out_size != OUT_TOTAL || ws_size < WS_END) { fprintf(stderr, "kernel_launch: unexpected shapes (n_in %d, out %d, ws %zu)\n", n_in, out_size, ws_size); grid_blocks = -1; return; }
        int dev = 0, cus = 0, per_cu = 0;
        hipGetDevice(&dev);
        hipDeviceGetAttribute(&cus, hipDeviceAttributeMultiprocessorCount, dev);
        hipFuncSetAttribute((const void*)fwd_megakernel, hipFuncAttributeMaxDynamicSharedMemorySize, LDS_BYTES);
        hipOccupancyMaxActiveBlocksPerMultiprocessor(&per_cu, (const void*)fwd_megakernel, NTHREADS, LDS_BYTES);
        if (per_cu < 1) { fprintf(stderr, "kernel_launch: occupancy query says %d blocks per CU\n", per_cu); per_cu = 1; }
        (void)hipGetLastError();
        grid_blocks = cus * per_cu;
    }
    if (grid_blocks < 0) return;
    Args a{};
    for (int i = 0; i < 26; ++i) a.in[i] = (const float*)d_in[i];
    a.out = (float*)d_out; a.ws = (unsigned char*)d_ws;
    if (hipMemsetAsync((char*)d_ws + WS_CTL, 0, 1 * MiB, stream) != hipSuccess) { fprintf(stderr, "kernel_launch: memset failed\n"); return; }
    void* args[] = {&a};
    hipError_t e = hipLaunchCooperativeKernel((const void*)fwd_megakernel, dim3(grid_blocks), dim3(NTHREADS), args, LDS_BYTES, stream);
    if (e != hipSuccess) fprintf(stderr, "cooperative launch failed: %s (grid %d)\n", hipGetErrorString(e), grid_blocks);
}
```

```cpp
#include <hip/hip_runtime.h>
#include <hip/hip_cooperative_groups.h>
#include <cstdio>
#include <cstdint>
namespace cg = cooperative_groups;

#define LAS __attribute__((address_space(3)))
typedef unsigned short bf16;
typedef short bf16x8 __attribute__((ext_vector_type(8)));
typedef float f32x4 __attribute__((ext_vector_type(4)));
typedef float f32x2 __attribute__((ext_vector_type(2)));
typedef unsigned u32x4 __attribute__((ext_vector_type(4)));
typedef unsigned u32x2 __attribute__((ext_vector_type(2)));

constexpr int D = 1024, SEQ = 2048, NBP = 8, MP = NBP * SEQ, NBS = 128, TS = 8, MS = NBS * TS, M = MP + MS;
constexpr int FF = 2816, NMEM = 256, NH = 4, HD = 256, DPOOL = 512, DCONV = 512, NZ = 2048, MMEM = NBP * NMEM;
constexpr int POOL_HIST = 15, CONV_HIST = 2;
constexpr float EPS = 1e-6f;
constexpr int NWAVES = 8, NTHREADS = 512;
#ifndef PHM
#define PHM 0xffff
#endif

constexpr size_t OUT_Y = 0;
constexpr size_t OUT_POOL_P = (size_t)M * D;
constexpr size_t OUT_CONV_P = OUT_POOL_P + (size_t)NBP * POOL_HIST * DPOOL;
constexpr size_t OUT_K_P = OUT_CONV_P + (size_t)NBP * CONV_HIST * DCONV;
constexpr size_t OUT_V_P = OUT_K_P + (size_t)MMEM * D;
constexpr size_t OUT_POOL_S = OUT_V_P + (size_t)MMEM * D;
constexpr size_t OUT_CONV_S = OUT_POOL_S + (size_t)NBS * POOL_HIST * DPOOL;
constexpr size_t OUT_TOTAL = OUT_CONV_S + (size_t)NBS * CONV_HIST * DCONV;

constexpr size_t MiB = 1u << 20;
constexpr size_t WS_CTL = 0;
constexpr size_t WS_W1IN = 1 * MiB, WS_W1OUT = 12 * MiB, WS_WMIX = 18 * MiB, WS_WEFF = 22 * MiB, WS_WXQ = 24 * MiB, WS_WXKV = 26 * MiB, WS_WXO = 30 * MiB;
constexpr size_t WS_W2IN = 32 * MiB, WS_W2OUT = 43 * MiB, WS_MEMN = 49 * MiB, WS_KB = 53 * MiB, WS_VT = 57 * MiB, WS_SSQ = 61 * MiB;
constexpr size_t WS_XB0 = 64 * MiB, WS_XB1 = 98 * MiB, WS_XB2 = 132 * MiB, WS_XB3 = 166 * MiB, WS_ACT = 200 * MiB, WS_Z = 294 * MiB, WS_A4 = 362 * MiB, WS_QB = 396 * MiB, WS_OB = 430 * MiB, WS_END = 464 * MiB;
constexpr size_t SSQ_STRIDE = 512 * 1024;

constexpr int RING_BYTES = 131072, LDS_T_OFF = RING_BYTES, LDS_MISC_OFF = LDS_T_OFF + 4096, LDS_BYTES = 147456;
constexpr int CW_BAR = 4096;

#define LDS_WAIT() asm volatile("s_waitcnt lgkmcnt(0)" ::: "memory")
#define VM_WAIT() asm volatile("s_waitcnt vmcnt(0)" ::: "memory")

__device__ __forceinline__ unsigned f2bf(float f) { unsigned u = __builtin_bit_cast(unsigned, f); return (u + 0x7fffu + ((u >> 16) & 1u)) >> 16; }
__device__ __forceinline__ unsigned pk2(float lo, float hi) { return f2bf(lo) | (f2bf(hi) << 16); }
__device__ __forceinline__ float bf_lo(unsigned w) { return __builtin_bit_cast(float, w << 16); }
__device__ __forceinline__ float bf_hi(unsigned w) { return __builtin_bit_cast(float, w & 0xffff0000u); }
__device__ __forceinline__ unsigned cvt_pk_bf16(float lo, float hi) { unsigned r; asm volatile("v_cvt_pk_bf16_f32 %0, %1, %2" : "=v"(r) : "v"(lo), "v"(hi)); return r; }
__device__ __forceinline__ float wave_sum(float v) {
#pragma unroll
    for (int o = 1; o < 64; o <<= 1) v += __shfl_xor(v, o);
    return v;
}
__device__ __forceinline__ float silu_f(float g) { return g * __builtin_amdgcn_rcpf(1.0f + __builtin_amdgcn_exp2f(-1.44269504089f * g)); }
__device__ __forceinline__ float row_rs(const float* ssq, int row) { const f32x4 s = *(const f32x4*)(ssq + 4 * (size_t)row); return rsqrtf(((s.x + s.y) + (s.z + s.w)) * (1.0f / D) + EPS); }

namespace pg8 {
constexpr int BM = 256, BK = 64, HALF = 128, HTB = HALF * BK * 2, NXCD = 8, WGM = 8;
__host__ __device__ __forceinline__ int lds_byte(int r, int c) { const int st = (r >> 4) * 2 + (c >> 5), rr = r & 15, cc = c & 31, ob = rr * 64 + cc * 2; return st * 1024 + (ob ^ (((ob >> 9) & 1) << 5)); }
__host__ __device__ __forceinline__ void stage_rc(int b, int& R, int& C) { const int st = b / 1024, sb = b % 1024, swz = sb ^ (((sb >> 9) & 1) << 5); R = (st >> 1) * 16 + swz / 64; C = (st & 1) * 32 + (swz % 64) / 2; }
__host__ __device__ __forceinline__ int perm32(int rho) { const int n = rho >> 4, i = rho & 15; return 8 * (i >> 2) + 4 * n + (i & 3); }

struct Unit { int pm, pn; };
struct Gemm { const bf16* A; const bf16* Bt; int M, N, K; };

struct StaticOrder {
    int nM, nN, nwg, G, c;
    __device__ void init(int M_, int N_, int G_, int c_) { nM = M_ / BM; nN = N_ / BM; nwg = nM * nN; G = G_; c = c_; }
    __device__ bool next(int i, Unit& u) const {
        const long L = (long)i * G + c; if (L >= nwg) return false;
        int wgid = (int)L; { const int q = nwg / NXCD, r = nwg % NXCD, xcd = wgid % NXCD, off = wgid / NXCD; wgid = (xcd < r ? xcd * (q + 1) : r * (q + 1) + (xcd - r) * q) + off; }
        const int nig = WGM * nN, gid = wgid / nig, fm = gid * WGM, gsz = (nM - fm) < WGM ? (nM - fm) : WGM;
        u.pm = fm + ((wgid % nig) % gsz); u.pn = (wgid % nig) / gsz; return true;
    }
    __device__ __forceinline__ void a_ready(const Unit&) const {}
    __device__ __forceinline__ void done(const Unit&) const {}
};

template <class Epi, class Sched, bool ALIGN_EPI = true, bool SP2 = true>
__device__ __forceinline__ void gemm_phase(LAS unsigned char* lds, const Gemm g, const Sched& S, const Epi& E) {
    int tid_ = threadIdx.x; asm volatile("" : "+v"(tid_));
    const int tid = tid_, wid = __builtin_amdgcn_readfirstlane(tid >> 6), lane = tid & 63, wr = wid >> 2, wc = wid & 3, fr = lane & 15, fq = lane >> 4;
    const int K = g.K, nt = K / BK;
    unsigned voffA[2], voffB[2];
#pragma unroll
    for (int i = 0; i < 2; ++i) { int R, C; stage_rc(tid * 16 + i * 8192, R, C); const int Rb = Epi::PERM ? ((R & ~31) + perm32(R & 31)) : R;
        voffA[i] = (unsigned)(R * K + C) * 2u; voffB[i] = (unsigned)(Rb * K + C) * 2u; }
    const size_t kstep = (size_t)(BK * 2);
    const size_t hstep = (size_t)HALF * K * 2;
    const size_t tstep = 2 * hstep;
    const unsigned ldsw = (unsigned)wid * 1024u;
    const int aoff = lds_byte(wr * 64 + fr, fq * 8), boff = lds_byte(wc * 32 + fr, fq * 8);
#define PG8_SA(b, h) (((b) * 2 + (h)) * HTB)
#define PG8_SB(b, h) ((4 + (b) * 2 + (h)) * HTB)
#define PG8_STAGE(bufoff, gbase, voff) do { _Pragma("unroll") for (int _i = 0; _i < 2; ++_i) \
        __builtin_amdgcn_global_load_lds((const unsigned*)((const char*)(gbase) + (voff)[_i]), (LAS unsigned*)(lds + (bufoff) + ldsw + _i * 8192), 16, 0, 0); } while (0)
#define PG8_LDA(dst, b, h) do { _Pragma("unroll") for (int m = 0; m < 4; ++m) _Pragma("unroll") for (int k = 0; k < 2; ++k) dst[m][k] = *(const LAS bf16x8*)(lds + PG8_SA(b, h) + aoff + m * 2048 + k * 1024); } while (0)
#define PG8_LDB(dst, b, h) do { _Pragma("unroll") for (int n = 0; n < 2; ++n) _Pragma("unroll") for (int k = 0; k < 2; ++k) dst[n][k] = *(const LAS bf16x8*)(lds + PG8_SB(b, h) + boff + n * 2048 + k * 1024); } while (0)
#define PG8_MMA(ai, bj, At, Bt) do { __builtin_amdgcn_s_setprio(1); _Pragma("unroll") for (int m = 0; m < 4; ++m) _Pragma("unroll") for (int n = 0; n < 2; ++n) _Pragma("unroll") for (int k = 0; k < 2; ++k) \
        acc[ai][bj][m][n] = __builtin_amdgcn_mfma_f32_16x16x32_bf16(Bt[n][k], At[m][k], acc[ai][bj][m][n], 0, 0, 0); __builtin_amdgcn_s_setprio(0); } while (0)
#define PG8_WAIT_V(n) asm volatile("s_waitcnt vmcnt(" #n ")" ::: "memory")
#define PG8_WAIT_L(n) asm volatile("s_waitcnt lgkmcnt(" #n ")" ::: "memory")
#define PG8_BAR __builtin_amdgcn_s_barrier()
#define PG8_SCHED __builtin_amdgcn_sched_barrier(0)
    Unit cur, nxt; int ui = 0;
    if (!S.next(0, cur)) return;
    f32x4 acc[2][2][4][2];
#pragma unroll
    for (int a = 0; a < 2; ++a)
#pragma unroll
        for (int b = 0; b < 2; ++b)
#pragma unroll
            for (int m = 0; m < 4; ++m)
#pragma unroll
                for (int n = 0; n < 2; ++n) acc[a][b][m][n] = (f32x4){0.f, 0.f, 0.f, 0.f};
    bf16x8 At[4][2], B0[2][2], B1[2][2];
    const char* cA = (const char*)g.A + (size_t)cur.pm * tstep; const char* cB = (const char*)g.Bt + (size_t)cur.pn * tstep;
    S.a_ready(cur);
    if constexpr (SP2) {
        PG8_STAGE(PG8_SB(0, 0), cB, voffB); PG8_STAGE(PG8_SB(0, 1), cB + hstep, voffB); PG8_STAGE(PG8_SA(0, 0), cA, voffA); PG8_STAGE(PG8_SA(0, 1), cA + hstep, voffA);
        if (wr == 1) PG8_BAR;
        PG8_WAIT_V(2); PG8_BAR;
        PG8_STAGE(PG8_SB(1, 0), cB + kstep, voffB); PG8_STAGE(PG8_SA(1, 0), cA + kstep, voffA); PG8_STAGE(PG8_SB(1, 1), cB + hstep + kstep, voffB);
        PG8_WAIT_V(6); PG8_BAR;
    } else {
        PG8_STAGE(PG8_SB(0, 0), cB, voffB); PG8_STAGE(PG8_SA(0, 0), cA, voffA); PG8_STAGE(PG8_SB(0, 1), cB + hstep, voffB); PG8_STAGE(PG8_SA(0, 1), cA + hstep, voffA);
        if (wr == 1) PG8_BAR;
        PG8_WAIT_V(4); PG8_BAR;
        PG8_STAGE(PG8_SB(1, 0), cB + kstep, voffB); PG8_STAGE(PG8_SA(1, 0), cA + kstep, voffA); PG8_STAGE(PG8_SB(1, 1), cB + hstep + kstep, voffB);
        PG8_WAIT_V(6); PG8_BAR;
    }
    for (;;) {
        const bool has_next = S.next(ui + 1, nxt);
        const char* nA = has_next ? (const char*)g.A + (size_t)nxt.pm * tstep : cA; const char* nB = has_next ? (const char*)g.Bt + (size_t)nxt.pn * tstep : cB;
        for (int t = 0; t < nt; t += 2) {
            const bool last = (t == nt - 2);
            const char* a1 = cA + (size_t)(t + 1) * kstep;
            const char* a2 = last ? nA : cA + (size_t)(t + 2) * kstep; const char* b2 = last ? nB : cB + (size_t)(t + 2) * kstep;
            const char* a3 = a2 + kstep; const char* b3 = b2 + kstep;
            if (last && has_next) S.a_ready(nxt);
            if constexpr (SP2) {
            PG8_LDB(B0, 0, 0); PG8_LDB(B1, 0, 1); PG8_SCHED; PG8_LDA(At, 0, 0); PG8_STAGE(PG8_SA(1, 1), a1 + hstep, voffA);
            PG8_WAIT_V(8); PG8_WAIT_L(0); PG8_BAR; PG8_MMA(0, 0, At, B0); PG8_MMA(0, 1, At, B1); PG8_BAR; PG8_SCHED;
            PG8_LDA(At, 0, 1); PG8_STAGE(PG8_SB(0, 0), b2, voffB); PG8_STAGE(PG8_SB(0, 1), b2 + hstep, voffB); PG8_STAGE(PG8_SA(0, 0), a2, voffA);
            PG8_WAIT_V(8); PG8_WAIT_L(0); PG8_BAR; PG8_MMA(1, 0, At, B0); PG8_MMA(1, 1, At, B1); PG8_BAR; PG8_SCHED;
            PG8_LDB(B0, 1, 0); PG8_LDB(B1, 1, 1); PG8_SCHED; PG8_LDA(At, 1, 0); PG8_STAGE(PG8_SA(0, 1), a2 + hstep, voffA);
            PG8_WAIT_V(8); PG8_WAIT_L(0); PG8_BAR; PG8_MMA(0, 0, At, B0); PG8_MMA(0, 1, At, B1); PG8_BAR; PG8_SCHED;
            PG8_LDA(At, 1, 1); PG8_STAGE(PG8_SB(1, 0), b3, voffB); PG8_STAGE(PG8_SB(1, 1), b3 + hstep, voffB); PG8_STAGE(PG8_SA(1, 0), a3, voffA);
            PG8_WAIT_V(8); PG8_WAIT_L(0); PG8_BAR; PG8_MMA(1, 0, At, B0); PG8_MMA(1, 1, At, B1); PG8_BAR; PG8_SCHED;
            } else {
            PG8_LDB(B0, 0, 0); PG8_SCHED; PG8_LDA(At, 0, 0); PG8_STAGE(PG8_SA(1, 1), a1 + hstep, voffA);
            PG8_WAIT_L(8); PG8_BAR; PG8_WAIT_L(0); PG8_MMA(0, 0, At, B0); PG8_BAR; PG8_SCHED;
            PG8_LDB(B1, 0, 1); PG8_STAGE(PG8_SB(0, 0), b2, voffB);
            PG8_BAR; PG8_WAIT_L(0); PG8_MMA(0, 1, At, B1); PG8_BAR;
            PG8_LDA(At, 0, 1); PG8_STAGE(PG8_SA(0, 0), a2, voffA);
            PG8_BAR; PG8_WAIT_L(0); PG8_MMA(1, 0, At, B0); PG8_BAR; PG8_SCHED;
            PG8_STAGE(PG8_SB(0, 1), b2 + hstep, voffB);
            PG8_WAIT_V(6); PG8_BAR; PG8_MMA(1, 1, At, B1); PG8_BAR;
            PG8_LDB(B0, 1, 0); PG8_SCHED; PG8_LDA(At, 1, 0); PG8_STAGE(PG8_SA(0, 1), a2 + hstep, voffA);
            PG8_WAIT_L(8); PG8_BAR; PG8_WAIT_L(0); PG8_MMA(0, 0, At, B0); PG8_BAR; PG8_SCHED;
            PG8_LDB(B1, 1, 1); PG8_STAGE(PG8_SB(1, 0), b3, voffB);
            PG8_BAR; PG8_WAIT_L(0); PG8_MMA(0, 1, At, B1); PG8_BAR;
            PG8_LDA(At, 1, 1); PG8_STAGE(PG8_SA(1, 0), a3, voffA);
            PG8_BAR; PG8_WAIT_L(0); PG8_MMA(1, 0, At, B0); PG8_BAR; PG8_SCHED;
            PG8_STAGE(PG8_SB(1, 1), b3 + hstep, voffB);
            PG8_WAIT_V(6); PG8_BAR; PG8_MMA(1, 1, At, B1); PG8_BAR;
            }
        }
        if constexpr (ALIGN_EPI) { if (wr == 0) PG8_BAR; }
        E(acc, cur, wr, wc, fr, fq, lds, tid); S.done(cur);
        if (!has_next) break;
#pragma unroll
        for (int a = 0; a < 2; ++a)
#pragma unroll
            for (int b = 0; b < 2; ++b)
#pragma unroll
                for (int m = 0; m < 4; ++m)
#pragma unroll
                    for (int n = 0; n < 2; ++n) acc[a][b][m][n] = (f32x4){0.f, 0.f, 0.f, 0.f};
        cur = nxt; cA = nA; cB = nB; ++ui;
        if constexpr (ALIGN_EPI) { if (wr == 1) PG8_BAR; }
    }
    PG8_WAIT_V(0);
    if constexpr (!ALIGN_EPI) { if (wr == 0) PG8_BAR; }
    PG8_BAR;
#undef PG8_SA
#undef PG8_SB
#undef PG8_STAGE
#undef PG8_LDA
#undef PG8_LDB
#undef PG8_MMA
#undef PG8_WAIT_V
#undef PG8_WAIT_L
#undef PG8_BAR
#undef PG8_SCHED
}
}

typedef f32x4 AccT[2][2][4][2];

struct EpiSwiGLU {
    static constexpr bool PERM = true;
    bf16* O; const float* ssq;
    __device__ __forceinline__ void operator()(const AccT& acc, const pg8::Unit& u, int wr, int wc, int fr, int fq, LAS unsigned char*, int) const {
        const int row0 = u.pm * 256 + wr * 64 + fr, col0 = u.pn * 128 + wc * 32 + 8 * fq;
#pragma unroll
        for (int ai = 0; ai < 2; ++ai)
#pragma unroll
            for (int m = 0; m < 4; ++m) {
                const int row = row0 + ai * 128 + m * 16; const float rs = row_rs(ssq, row);
                float v[8];
#pragma unroll
                for (int n = 0; n < 2; ++n)
#pragma unroll
                    for (int j = 0; j < 4; ++j) { const float gt = acc[ai][0][m][n][j] * rs, up = acc[ai][1][m][n][j] * rs; v[n * 4 + j] = silu_f(gt) * up; }
                u32x4 w; w.x = cvt_pk_bf16(v[0], v[1]); w.y = cvt_pk_bf16(v[2], v[3]); w.z = cvt_pk_bf16(v[4], v[5]); w.w = cvt_pk_bf16(v[6], v[7]);
                *(u32x4*)(O + (size_t)row * FF + col0) = w;
            }
    }
};

struct EpiScaleBf16 {
    static constexpr bool PERM = true;
    bf16* O; int ldc; const float* ssq; float cmul;
    __device__ __forceinline__ void operator()(const AccT& acc, const pg8::Unit& u, int wr, int wc, int fr, int fq, LAS unsigned char*, int) const {
        const int row0 = u.pm * 256 + wr * 64 + fr, col0 = u.pn * 256 + wc * 32 + 8 * fq;
#pragma unroll
        for (int ai = 0; ai < 2; ++ai)
#pragma unroll
            for (int m = 0; m < 4; ++m) {
                const int row = row0 + ai * 128 + m * 16; const float rs = row_rs(ssq, row) * cmul;
#pragma unroll
                for (int bj = 0; bj < 2; ++bj) { const f32x4 v0 = acc[ai][bj][m][0] * rs, v1 = acc[ai][bj][m][1] * rs;
                    u32x4 w; w.x = cvt_pk_bf16(v0[0], v0[1]); w.y = cvt_pk_bf16(v0[2], v0[3]); w.z = cvt_pk_bf16(v1[0], v1[1]); w.w = cvt_pk_bf16(v1[2], v1[3]);
                    *(u32x4*)(O + (size_t)row * ldc + col0 + bj * 128) = w; }
            }
    }
};

struct EpiRes {
    static constexpr bool PERM = true;
    const float* resP; const float* resS;
    float* out; bf16* xb; float* ssq; float alpha;
    __device__ __forceinline__ void operator()(const AccT& acc, const pg8::Unit& u, int wr, int wc, int fr, int fq, LAS unsigned char* lds, int tid) const {
        const float* res = (u.pm < 64) ? resP + (size_t)u.pm * 256 * D : resS + (size_t)(u.pm - 64) * 256 * D;
        float* outp = out + (size_t)u.pm * 256 * D;
        const int col0 = u.pn * 256 + wc * 32 + 8 * fq;
        LAS float* T = (LAS float*)(lds + LDS_T_OFF);
#pragma unroll
        for (int ai = 0; ai < 2; ++ai)
#pragma unroll
            for (int m = 0; m < 4; ++m) {
                const int r = ai * 128 + wr * 64 + m * 16 + fr; const size_t off = (size_t)r * D + col0;
                f32x4 x[2][2]; float s = 0.f;
#pragma unroll
                for (int bj = 0; bj < 2; ++bj)
#pragma unroll
                    for (int n = 0; n < 2; ++n) { const f32x4 bs = *(const f32x4*)(res + off + bj * 128 + n * 4); const f32x4 v = bs + acc[ai][bj][m][n] * alpha; x[bj][n] = v;
                        s += (v[0] * v[0] + v[1] * v[1]) + (v[2] * v[2] + v[3] * v[3]); }
#pragma unroll
                for (int bj = 0; bj < 2; ++bj) {
                    *(f32x4*)(outp + off + bj * 128) = x[bj][0]; *(f32x4*)(outp + off + bj * 128 + 4) = x[bj][1];
                    if (xb) { u32x4 w; w.x = cvt_pk_bf16(x[bj][0][0], x[bj][0][1]); w.y = cvt_pk_bf16(x[bj][0][2], x[bj][0][3]); w.z = cvt_pk_bf16(x[bj][1][0], x[bj][1][1]); w.w = cvt_pk_bf16(x[bj][1][2], x[bj][1][3]);
                        *(u32x4*)(xb + (size_t)u.pm * 256 * D + off + bj * 128) = w; }
                }
                if (ssq) { s += __shfl_xor(s, 16); s += __shfl_xor(s, 32); if (fq == 0) T[r * 4 + wc] = s; }
                asm volatile("" ::: "memory");
            }
        if (ssq) {
            LDS_WAIT(); __builtin_amdgcn_s_barrier(); asm volatile("" ::: "memory");
            if (tid < 256) { const f32x4 t = *(const LAS f32x4*)(T + tid * 4); ssq[(size_t)(u.pm * 256 + tid) * 4 + u.pn] = (t.x + t.y) + (t.z + t.w); }
        }
    }
};

struct EpiKV {
    static constexpr bool PERM = true;
    float* outK; float* outV; bf16* KB; bf16* VT; const float* ssq;
    __device__ __forceinline__ void operator()(const AccT& acc, const pg8::Unit& u, int wr, int wc, int fr, int fq, LAS unsigned char*, int) const {
        const bool isV = u.pn >= 4; const int hh = u.pn & 3;
        float* o32 = isV ? outV : outK;
        const int col0 = hh * 256 + wc * 32 + 8 * fq;
#pragma unroll
        for (int ai = 0; ai < 2; ++ai)
#pragma unroll
            for (int m = 0; m < 4; ++m) {
                const int key = ai * 128 + wr * 64 + m * 16 + fr, row = u.pm * 256 + key; const float rs = row_rs(ssq, row);
#pragma unroll
                for (int bj = 0; bj < 2; ++bj) { const f32x4 v0 = acc[ai][bj][m][0] * rs, v1 = acc[ai][bj][m][1] * rs;
                    float* op = o32 + (size_t)row * D + col0 + bj * 128; *(f32x4*)op = v0; *(f32x4*)(op + 4) = v1;
                    if (!isV) { u32x4 w; w.x = cvt_pk_bf16(v0[0], v0[1]); w.y = cvt_pk_bf16(v0[2], v0[3]); w.z = cvt_pk_bf16(v1[0], v1[1]); w.w = cvt_pk_bf16(v1[2], v1[3]);
                        *(u32x4*)(KB + (size_t)row * D + col0 + bj * 128) = w; }
                    else { const int d0 = wc * 32 + 8 * fq + bj * 128; bf16* vp = VT + ((size_t)(u.pm * 4 + hh) * 256 + d0) * 256 + key;
#pragma unroll
                        for (int j = 0; j < 4; ++j) { vp[(size_t)j * 256] = (bf16)f2bf(v0[j]); vp[(size_t)(4 + j) * 256] = (bf16)f2bf(v1[j]); } }
                }
            }
    }
};


#define XB_TMO      128
#define XB_XCNT(j)  (256  + 64 * (j))
#define XB_XSUB(j)  (1280 + 64 * (j))
#define XB_XGEN(j)  (2304 + 64 * (j))
#define XB_TOP      3328
#define XB_TOPGEN   3392
#define XCD_BAR_WORDS 3456
#define XB_SPIN_CAP (1u << 22)
__device__ __forceinline__ unsigned xb_ld(unsigned* p)              { return __hip_atomic_load(p, __ATOMIC_RELAXED, __HIP_MEMORY_SCOPE_AGENT); }
__device__ __forceinline__ unsigned xb_add(unsigned* p, unsigned v) { return __hip_atomic_fetch_add(p, v, __ATOMIC_RELAXED, __HIP_MEMORY_SCOPE_AGENT); }
__device__ __forceinline__ unsigned xb_xcc_id() { return (unsigned)__builtin_amdgcn_s_getreg((3 << 11) | 20) & 0xFu; }
#define XB_SPIN(cond, bar) do { unsigned _sp = 0; while (cond) { __builtin_amdgcn_s_sleep(1); \
    if ((++_sp & 255u) == 0u) { if (xb_ld(&(bar)[XB_TMO])) break; if (_sp > XB_SPIN_CAP) { atomicAdd(&(bar)[XB_TMO], 1u); break; } } } } while (0)
struct XcdBarrier { unsigned* bar; unsigned x; volatile LAS unsigned* st; };
__device__ __forceinline__ XcdBarrier xcd_barrier_post(unsigned* bar, volatile LAS unsigned* st) {
    XcdBarrier b; b.bar = bar; b.x = xb_xcc_id(); b.st = st;
    if (threadIdx.x == 0) (void)xb_add(&bar[XB_XCNT(b.x)], 1u);
    return b;
}
__device__ __forceinline__ void xcd_barrier_complete(unsigned* bar, unsigned x, unsigned& nloc, unsigned& nx) {
    const unsigned G = gridDim.x * gridDim.y * gridDim.z;
    unsigned sum, cnt, mine, sp = 0u;
    for (;;) {
        sum = 0u; cnt = 0u; mine = 0u;
#pragma unroll
        for (unsigned j = 0; j < 16; ++j) { const unsigned c = xb_ld(&bar[XB_XCNT(j)]); sum += c; cnt += (c > 0u) ? 1u : 0u; mine = (j == x) ? c : mine; }
        if (sum == G) break;
        __builtin_amdgcn_s_sleep(1);
        if ((++sp & 255u) == 0u) { if (xb_ld(&bar[XB_TMO])) break; if (sp > XB_SPIN_CAP) { atomicAdd(&bar[XB_TMO], 1u); break; } }
    }
    nloc = mine > 0u ? mine : 1u; nx = cnt > 0u ? cnt : 1u;
}
__device__ __forceinline__ void xcd_barrier(const XcdBarrier& b) {
    asm volatile("s_waitcnt vmcnt(0)" ::: "memory");
    __syncthreads();
    if (threadIdx.x == 0) {
        unsigned* bar = b.bar;
        __builtin_amdgcn_s_waitcnt(0);
        unsigned nloc = b.st[0], nx = b.st[1];
        if (nloc == 0u) { xcd_barrier_complete(bar, b.x, nloc, nx); b.st[0] = nloc; b.st[1] = nx; }
        const unsigned old = xb_add(&bar[XB_XSUB(b.x)], 1u);
        const unsigned gen = old / nloc;
        if (old + 1u == (gen + 1u) * nloc) {
            __builtin_amdgcn_fence(__ATOMIC_RELEASE, "agent");
            asm volatile("s_waitcnt vmcnt(0)" ::: "memory");
            const unsigned og = xb_add(&bar[XB_TOP], 1u);
            const unsigned tg = og / nx;
            if (og + 1u == (tg + 1u) * nx) xb_add(&bar[XB_TOPGEN], 1u);
            else XB_SPIN(xb_ld(&bar[XB_TOPGEN]) == tg, bar);
            __builtin_amdgcn_fence(__ATOMIC_ACQUIRE, "agent");
            xb_add(&bar[XB_XGEN(b.x)], 1u);
            asm volatile("s_waitcnt vmcnt(0)" ::: "memory");
        } else {
            XB_SPIN(xb_ld(&bar[XB_XGEN(b.x)]) == gen, bar);
            __builtin_amdgcn_fence(__ATOMIC_ACQUIRE, "agent");
            asm volatile("s_waitcnt vmcnt(0)" ::: "memory");
        }
    }
    __syncthreads();
}

struct Args {
    const float* in[26];
    float* out; unsigned char* ws;
};

struct Ctx { int tid, lane, wave, gw, NGW, G; LAS unsigned char* lds; };

__device__ __forceinline__ void p0_transpose_item(const float* W, int K, int N, bf16* WT, int ldk, const float* gk, float cmul, int mode, int row_off, int kbeg, LAS float* scr, int item, int lane) {
    const int nblk = N / 32, kb = item / nblk, nb = item % nblk, k0 = kbeg + 64 * kb, n0 = 32 * nb;
#pragma unroll 8
    for (int i = 0; i < 32; ++i) { const int kk = 2 * i + (lane >> 5); const float sc = (gk ? gk[k0 + kk] : 1.0f) * cmul; scr[kk * 33 + (lane & 31)] = W[(size_t)(k0 + kk) * N + n0 + (lane & 31)] * sc; }
    LDS_WAIT();
    const int c = lane & 7;
#pragma unroll
    for (int j = 0; j < 4; ++j) { const int n = (lane >> 3) + 8 * j; const LAS float* s = scr + (8 * c) * 33 + n;
        u32x4 o; o.x = pk2(s[0 * 33], s[1 * 33]); o.y = pk2(s[2 * 33], s[3 * 33]); o.z = pk2(s[4 * 33], s[5 * 33]); o.w = pk2(s[6 * 33], s[7 * 33]);
        const int ns = n0 + n; int dr;
        if (mode == 1) { const int half = ns >= FF ? 1 : 0, cc = ns - half * FF; dr = 256 * (cc >> 7) + 128 * half + (cc & 127); } else dr = row_off + ns;
        *(u32x4*)(WT + (size_t)dr * ldk + k0 + 8 * c) = o; }
    LDS_WAIT();
}
__device__ __forceinline__ void p0_weff_item(const float* pool_w, const float* pool_scale, const float* Wmo, bf16* WT, int item, int lane) {
    const int kb = item >> 5, nb = item & 31, k = kb * 64 + lane, g = k >> 7, n0 = nb * 32;
    const float* pw = pool_w + (size_t)k * 128;
    float acc[32];
#pragma unroll
    for (int n = 0; n < 32; ++n) acc[n] = 0.f;
    for (int dd = 0; dd < 128; dd += 4) {
        const f32x4 p4 = *(const f32x4*)(pw + dd);
#pragma unroll
        for (int e = 0; e < 4; ++e) {
            const float pv = p4[e] * pool_scale[g * 128 + dd + e];
            const f32x4* wrow = (const f32x4*)(Wmo + (size_t)(g * 128 + dd + e) * D + n0);
#pragma unroll
            for (int n4 = 0; n4 < 8; ++n4) { const f32x4 w4 = wrow[n4]; acc[4 * n4] += pv * w4.x; acc[4 * n4 + 1] += pv * w4.y; acc[4 * n4 + 2] += pv * w4.z; acc[4 * n4 + 3] += pv * w4.w; }
        }
    }
#pragma unroll
    for (int n = 0; n < 32; ++n) WT[(size_t)(n0 + n) * D + k] = (bf16)f2bf(acc[n]);
}
__device__ __forceinline__ void p0_row(const float* xrow, bf16* orow, float* ssq4, int lane) {
    const f32x4* xr = (const f32x4*)xrow + lane;
    f32x4 v[4]; float s = 0.f;
#pragma unroll
    for (int j = 0; j < 4; ++j) { v[j] = xr[64 * j]; s += (v[j].x * v[j].x + v[j].y * v[j].y) + (v[j].z * v[j].z + v[j].w * v[j].w); }
    s = wave_sum(s);
    u32x2* o8 = (u32x2*)orow + lane;
#pragma unroll
    for (int j = 0; j < 4; ++j) { u32x2 w; w.x = pk2(v[j].x, v[j].y); w.y = pk2(v[j].z, v[j].w); o8[64 * j] = w; }
    if (lane == 0) *(f32x4*)ssq4 = (f32x4){s, 0.f, 0.f, 0.f};
}

__device__ __forceinline__ void p0_prologue(const Ctx& C, const Args& A) {
    unsigned char* ws = A.ws;
    LAS float* scr = (LAS float*)(C.lds + C.wave * 16384);
    constexpr int I_1IN = (D / 64) * (2 * FF / 32), I_1OUT = (FF / 64) * (D / 32), I_MIX = (D / 64) * (NZ / 32), I_MO = (512 / 64) * (D / 32), I_SQ = (D / 64) * (D / 32), I_EFF = 8 * 32;
    constexpr int NITEMS = 2 * I_1IN + 2 * I_1OUT + I_MIX + I_MO + 4 * I_SQ + I_EFF;
    for (int it = C.gw; it < NITEMS; it += C.NGW) {
        int r = it;
        if (r < I_EFF) { p0_weff_item(A.in[12], A.in[13], A.in[15], (bf16*)(ws + WS_WEFF), r, C.lane); continue; } r -= I_EFF;
        if (r < I_1IN) { p0_transpose_item(A.in[8], D, 2 * FF, (bf16*)(ws + WS_W1IN), D, A.in[7], 1.f, 1, 0, 0, scr, r, C.lane); continue; } r -= I_1IN;
        if (r < I_1IN) { p0_transpose_item(A.in[23], D, 2 * FF, (bf16*)(ws + WS_W2IN), D, A.in[22], 1.f, 1, 0, 0, scr, r, C.lane); continue; } r -= I_1IN;
        if (r < I_1OUT) { p0_transpose_item(A.in[9], FF, D, (bf16*)(ws + WS_W1OUT), FF, nullptr, 1.f, 0, 0, 0, scr, r, C.lane); continue; } r -= I_1OUT;
        if (r < I_1OUT) { p0_transpose_item(A.in[24], FF, D, (bf16*)(ws + WS_W2OUT), FF, nullptr, 1.f, 0, 0, 0, scr, r, C.lane); continue; } r -= I_1OUT;
        if (r < I_MIX) { p0_transpose_item(A.in[11], D, NZ, (bf16*)(ws + WS_WMIX), D, A.in[10], 1.f, 0, 0, 0, scr, r, C.lane); continue; } r -= I_MIX;
        if (r < I_MO) { p0_transpose_item(A.in[15], D, D, (bf16*)(ws + WS_WEFF), D, nullptr, 1.f, 0, 0, 512, scr, r, C.lane); continue; } r -= I_MO;
        if (r < I_SQ) { p0_transpose_item(A.in[18], D, D, (bf16*)(ws + WS_WXQ), D, A.in[16], 0.0625f, 0, 0, 0, scr, r, C.lane); continue; } r -= I_SQ;
        if (r < I_SQ) { p0_transpose_item(A.in[19], D, D, (bf16*)(ws + WS_WXKV), D, A.in[17], 1.f, 0, 0, 0, scr, r, C.lane); continue; } r -= I_SQ;
        if (r < I_SQ) { p0_transpose_item(A.in[20], D, D, (bf16*)(ws + WS_WXKV), D, A.in[17], 1.f, 0, D, 0, scr, r, C.lane); continue; } r -= I_SQ;
        p0_transpose_item(A.in[21], D, D, (bf16*)(ws + WS_WXO), D, nullptr, 1.f, 0, 0, 0, scr, r, C.lane);
    }
    bf16* XB0 = (bf16*)(ws + WS_XB0); float* SSQ0 = (float*)(ws + WS_SSQ);
    for (int m = C.gw; m < M; m += C.NGW) { const float* xr = (m < MP) ? A.in[0] + (size_t)m * D : A.in[1] + (size_t)(m - MP) * D; p0_row(xr, XB0 + (size_t)m * D, SSQ0 + 4 * (size_t)m, C.lane); }
    bf16* MEMN = (bf16*)(ws + WS_MEMN); float* SSQM = (float*)(ws + WS_SSQ + 4 * SSQ_STRIDE);
    for (int m = C.gw; m < MMEM; m += C.NGW) p0_row(A.in[2] + (size_t)m * D, MEMN + (size_t)m * D, SSQM + 4 * (size_t)m, C.lane);
}

__device__ __forceinline__ void unpack8(const u32x4 w, float (&f)[8]) { f[0] = bf_lo(w.x); f[1] = bf_hi(w.x); f[2] = bf_lo(w.y); f[3] = bf_hi(w.y); f[4] = bf_lo(w.z); f[5] = bf_hi(w.z); f[6] = bf_lo(w.w); f[7] = bf_hi(w.w); }
__device__ __forceinline__ void mix_row(const Args& A, int row, int lane) {
    const bf16* Z = (const bf16*)(A.ws + WS_Z); bf16* A4 = (bf16*)(A.ws + WS_A4);
    const bool smp = row >= MP; const int b = smp ? (row - MP) >> 3 : row >> 11, t = smp ? (row - MP) & 7 : row & (SEQ - 1);
    const int col = lane * 8;
    {
        const int gi = lane >> 4, w = 2 << gi;
        float sum[8], cur[8];
#pragma unroll
        for (int e = 0; e < 8; ++e) sum[e] = 0.f;
        unpack8(*(const u32x4*)(Z + (size_t)row * NZ + col), cur);
        for (int j = 0; j < 16; ++j) {
            if (j < w) {
                const int tt = t - j; float v[8];
                if (tt >= 0) unpack8(*(const u32x4*)(Z + (size_t)(row - j) * NZ + col), v);
                else if (smp) { const float* hp = A.in[3] + ((size_t)b * POOL_HIST + (POOL_HIST + tt)) * DPOOL + col; const f32x4 h0 = *(const f32x4*)hp, h1 = *(const f32x4*)(hp + 4);
                    v[0] = h0.x; v[1] = h0.y; v[2] = h0.z; v[3] = h0.w; v[4] = h1.x; v[5] = h1.y; v[6] = h1.z; v[7] = h1.w; }
                else {
#pragma unroll
                    for (int e = 0; e < 8; ++e) v[e] = 0.f; }
#pragma unroll
                for (int e = 0; e < 8; ++e) sum[e] += v[e];
            }
        }
        const int cnti = smp ? w : ((t + 1) < w ? (t + 1) : w); const float ic = 1.0f / (float)cnti;
        float d[8];
#pragma unroll
        for (int e = 0; e < 8; ++e) d[e] = sum[e] * ic - cur[e];
        u32x4 o; o.x = pk2(d[0], d[1]); o.y = pk2(d[2], d[3]); o.z = pk2(d[4], d[5]); o.w = pk2(d[6], d[7]);
        *(u32x4*)(A4 + (size_t)row * D + col) = o;
        if (!smp) { if (t >= SEQ - POOL_HIST) { float* op = A.out + OUT_POOL_P + ((size_t)b * POOL_HIST + (t - (SEQ - POOL_HIST))) * DPOOL + col; *(f32x4*)op = (f32x4){cur[0], cur[1], cur[2], cur[3]}; *(f32x4*)(op + 4) = (f32x4){cur[4], cur[5], cur[6], cur[7]}; } }
        else { float* op = A.out + OUT_POOL_S + ((size_t)b * POOL_HIST + (7 + t)) * DPOOL + col; *(f32x4*)op = (f32x4){cur[0], cur[1], cur[2], cur[3]}; *(f32x4*)(op + 4) = (f32x4){cur[4], cur[5], cur[6], cur[7]};
            if (t < 7) { const float* hp = A.in[3] + ((size_t)b * POOL_HIST + (8 + t)) * DPOOL + col; float* o2 = A.out + OUT_POOL_S + ((size_t)b * POOL_HIST + t) * DPOOL + col; *(f32x4*)o2 = *(const f32x4*)hp; *(f32x4*)(o2 + 4) = *(const f32x4*)(hp + 4); } }
    }
    {
        float u[3][8];
#pragma unroll
        for (int k = 0; k < 3; ++k) {
            const int tt = t - 2 + k;
            if (tt >= 0) { float cc[8], ch[8]; const bf16* zp = Z + (size_t)(row - 2 + k) * NZ + col; unpack8(*(const u32x4*)(zp + 1024), cc); unpack8(*(const u32x4*)(zp + 1536), ch);
#pragma unroll
                for (int e = 0; e < 8; ++e) u[k][e] = cc[e] * ch[e]; }
            else if (smp) { const float* hp = A.in[4] + ((size_t)b * CONV_HIST + (CONV_HIST + tt)) * DCONV + col; const f32x4 h0 = *(const f32x4*)hp, h1 = *(const f32x4*)(hp + 4);
                u[k][0] = h0.x; u[k][1] = h0.y; u[k][2] = h0.z; u[k][3] = h0.w; u[k][4] = h1.x; u[k][5] = h1.y; u[k][6] = h1.z; u[k][7] = h1.w; }
            else {
#pragma unroll
                for (int e = 0; e < 8; ++e) u[k][e] = 0.f; }
        }
        float cb[8]; unpack8(*(const u32x4*)(Z + (size_t)row * NZ + 512 + col), cb);
        const float* cw = A.in[14] + col; float y[8];
#pragma unroll
        for (int e = 0; e < 8; ++e) y[e] = cb[e] * (cw[e] * u[0][e] + cw[DCONV + e] * u[1][e] + cw[2 * DCONV + e] * u[2][e]);
        u32x4 o; o.x = pk2(y[0], y[1]); o.y = pk2(y[2], y[3]); o.z = pk2(y[4], y[5]); o.w = pk2(y[6], y[7]);
        *(u32x4*)(A4 + (size_t)row * D + 512 + col) = o;
        const int tl = smp ? TS : SEQ;
        if (t >= tl - CONV_HIST) { float* op = A.out + (smp ? OUT_CONV_S : OUT_CONV_P) + ((size_t)b * CONV_HIST + (t - (tl - CONV_HIST))) * DCONV + col;
            *(f32x4*)op = (f32x4){u[2][0], u[2][1], u[2][2], u[2][3]}; *(f32x4*)(op + 4) = (f32x4){u[2][4], u[2][5], u[2][6], u[2][7]}; }
    }
}

__device__ __forceinline__ void mix_row_prompt(const Args& A, int row, int lane) {
    const bf16* Z = (const bf16*)(A.ws + WS_Z); bf16* A4 = (bf16*)(A.ws + WS_A4);
    const int b = row >> 11, t = row & (SEQ - 1), col = lane * 8;
    const bf16* zr = Z + (size_t)row * NZ + col;
    u32x4 pv[16], ccv[3], chv[3];
#pragma unroll
    for (int j = 0; j < 16; ++j) { const int jj = j < t ? j : t; pv[j] = *(const u32x4*)(zr - (size_t)jj * NZ); }
#pragma unroll
    for (int k = 0; k < 3; ++k) { const int jj = (2 - k) < t ? (2 - k) : t; ccv[k] = *(const u32x4*)(zr - (size_t)jj * NZ + 1024); chv[k] = *(const u32x4*)(zr - (size_t)jj * NZ + 1536); }
    const u32x4 cbv = *(const u32x4*)(zr + 512);
    const f32x4 cw0a = *(const f32x4*)(A.in[14] + col), cw0b = *(const f32x4*)(A.in[14] + col + 4), cw1a = *(const f32x4*)(A.in[14] + DCONV + col), cw1b = *(const f32x4*)(A.in[14] + DCONV + col + 4),
                cw2a = *(const f32x4*)(A.in[14] + 2 * DCONV + col), cw2b = *(const f32x4*)(A.in[14] + 2 * DCONV + col + 4);
    const int gi = lane >> 4, w = 2 << gi;
    float sum[8], cur[8];
#pragma unroll
    for (int e = 0; e < 8; ++e) sum[e] = 0.f;
#pragma unroll
    for (int j = 0; j < 16; ++j) { float v[8]; unpack8(pv[j], v); const float mk = (j < w && j <= t) ? 1.f : 0.f;
        if (j == 0) {
#pragma unroll
            for (int e = 0; e < 8; ++e) cur[e] = v[e]; }
#pragma unroll
        for (int e = 0; e < 8; ++e) sum[e] += mk * v[e]; }
    const int cnti = (t + 1) < w ? (t + 1) : w; const float ic = 1.0f / (float)cnti;
    float d[8];
#pragma unroll
    for (int e = 0; e < 8; ++e) d[e] = sum[e] * ic - cur[e];
    u32x4 o; o.x = pk2(d[0], d[1]); o.y = pk2(d[2], d[3]); o.z = pk2(d[4], d[5]); o.w = pk2(d[6], d[7]);
    *(u32x4*)(A4 + (size_t)row * D + col) = o;
    if (t >= SEQ - POOL_HIST) { float* op = A.out + OUT_POOL_P + ((size_t)b * POOL_HIST + (t - (SEQ - POOL_HIST))) * DPOOL + col; *(f32x4*)op = (f32x4){cur[0], cur[1], cur[2], cur[3]}; *(f32x4*)(op + 4) = (f32x4){cur[4], cur[5], cur[6], cur[7]}; }
    float u[3][8];
#pragma unroll
    for (int k = 0; k < 3; ++k) { float cc[8], ch[8]; unpack8(ccv[k], cc); unpack8(chv[k], ch); const float mk = ((2 - k) <= t) ? 1.f : 0.f;
#pragma unroll
        for (int e = 0; e < 8; ++e) u[k][e] = mk * cc[e] * ch[e]; }
    float cb[8]; unpack8(cbv, cb);
    const float cw0[8] = {cw0a.x, cw0a.y, cw0a.z, cw0a.w, cw0b.x, cw0b.y, cw0b.z, cw0b.w}, cw1[8] = {cw1a.x, cw1a.y, cw1a.z, cw1a.w, cw1b.x, cw1b.y, cw1b.z, cw1b.w}, cw2[8] = {cw2a.x, cw2a.y, cw2a.z, cw2a.w, cw2b.x, cw2b.y, cw2b.z, cw2b.w};
    float y[8];
#pragma unroll
    for (int e = 0; e < 8; ++e) y[e] = cb[e] * (cw0[e] * u[0][e] + cw1[e] * u[1][e] + cw2[e] * u[2][e]);
    u32x4 o2; o2.x = pk2(y[0], y[1]); o2.y = pk2(y[2], y[3]); o2.z = pk2(y[4], y[5]); o2.w = pk2(y[6], y[7]);
    *(u32x4*)(A4 + (size_t)row * D + 512 + col) = o2;
    if (t >= SEQ - CONV_HIST) { float* op = A.out + OUT_CONV_P + ((size_t)b * CONV_HIST + (t - (SEQ - CONV_HIST))) * DCONV + col;
        *(f32x4*)op = (f32x4){u[2][0], u[2][1], u[2][2], u[2][3]}; *(f32x4*)(op + 4) = (f32x4){u[2][4], u[2][5], u[2][6], u[2][7]}; }
}

#define MFMA16(a, b, c) __builtin_amdgcn_mfma_f32_16x16x32_bf16(a, b, c, 0, 0, 0)
#define ATT_BAR() do { LDS_WAIT(); __builtin_amdgcn_s_barrier(); asm volatile("" ::: "memory"); } while (0)
__device__ __forceinline__ void attn_tile_load(u32x4 (&r)[4], const bf16* src, int pitch, int tid) {
    const int row = tid >> 3, c4 = tid & 7; const u32x4* p = (const u32x4*)(src + (size_t)row * pitch + c4 * 32);
#pragma unroll
    for (int i = 0; i < 4; ++i) r[i] = p[i];
}
__device__ __forceinline__ void attn_tile_write(const u32x4 (&r)[4], LAS unsigned char* buf, int tid) {
    const int row = tid >> 3, c4 = tid & 7;
#pragma unroll
    for (int i = 0; i < 4; ++i) *(LAS u32x4*)(buf + row * 512 + (((c4 * 4 + i) ^ (row & 15)) << 4)) = r[i];
}
__device__ __forceinline__ void attn_prompt_block(const bf16* Q, const bf16* KB, const bf16* VT, bf16* O, int b, int h, int qt, LAS unsigned char* lds, int tid) {
    const int lane = tid & 63, w = __builtin_amdgcn_readfirstlane(tid >> 6), c = lane & 15, g = lane >> 4;
    const size_t qrow = (size_t)b * SEQ + (size_t)qt * 128 + w * 16 + c;
    const bf16* Ksrc = KB + (size_t)b * NMEM * D + h * HD;
    const bf16* Vsrc = VT + (size_t)(b * NH + h) * HD * NMEM;
    u32x4 st[4];
    attn_tile_load(st, Ksrc, D, tid);
    bf16x8 Bq[8];
#pragma unroll
    for (int ks = 0; ks < 8; ++ks) Bq[ks] = *(const bf16x8*)(Q + qrow * D + h * HD + ks * 32 + 8 * g);
    f32x4 S[16];
#pragma unroll
    for (int kb = 0; kb < 16; ++kb) S[kb] = (f32x4){0.f, 0.f, 0.f, 0.f};
#pragma unroll
    for (int t = 0; t < 4; ++t) {
        LAS unsigned char* buf = lds + (t & 1) * 32768;
        attn_tile_write(st, buf, tid);
        if (t < 3) attn_tile_load(st, Ksrc + (size_t)(t + 1) * 64 * D, D, tid); else attn_tile_load(st, Vsrc, NMEM, tid);
        ATT_BAR();
#pragma unroll
        for (int kb = 0; kb < 4; ++kb)
#pragma unroll
            for (int ks = 0; ks < 8; ++ks) { const bf16x8 Ak = *(const LAS bf16x8*)(buf + kb * 8192 + c * 512 + (((ks * 4 + g) ^ c) << 4)); S[t * 4 + kb] = MFMA16(Ak, Bq[ks], S[t * 4 + kb]); }
    }
    float mx = -3.0e38f;
#pragma unroll
    for (int kb = 0; kb < 16; ++kb)
#pragma unroll
        for (int j = 0; j < 4; ++j) mx = fmaxf(mx, S[kb][j]);
    mx = fmaxf(mx, __shfl_xor(mx, 16)); mx = fmaxf(mx, __shfl_xor(mx, 32));
    float sm = 0.f;
#pragma unroll
    for (int kb = 0; kb < 16; ++kb)
#pragma unroll
        for (int j = 0; j < 4; ++j) { const float p = __builtin_amdgcn_exp2f((S[kb][j] - mx) * 1.44269504089f); S[kb][j] = p; sm += p; }
    sm += __shfl_xor(sm, 16); sm += __shfl_xor(sm, 32);
    const float inv = 1.0f / sm;
    bf16x8 Pa[8];
#pragma unroll
    for (int s = 0; s < 8; ++s) { u32x4 wv; wv.x = cvt_pk_bf16(S[2 * s][0], S[2 * s][1]); wv.y = cvt_pk_bf16(S[2 * s][2], S[2 * s][3]);
        wv.z = cvt_pk_bf16(S[2 * s + 1][0], S[2 * s + 1][1]); wv.w = cvt_pk_bf16(S[2 * s + 1][2], S[2 * s + 1][3]); Pa[s] = __builtin_bit_cast(bf16x8, wv); }
#pragma unroll
    for (int t = 4; t < 8; ++t) {
        LAS unsigned char* buf = lds + (t & 1) * 32768;
        attn_tile_write(st, buf, tid);
        if (t < 7) attn_tile_load(st, Vsrc + (size_t)(t - 3) * 64 * NMEM, NMEM, tid);
        ATT_BAR();
#pragma unroll
        for (int db = 0; db < 4; ++db) {
            f32x4 o = (f32x4){0.f, 0.f, 0.f, 0.f};
#pragma unroll
            for (int s = 0; s < 8; ++s) { const LAS unsigned char* rp = buf + db * 8192 + c * 512 + 8 * (g & 1);
                const u32x2 lo = *(const LAS u32x2*)(rp + (((4 * s + (g >> 1)) ^ c) << 4)), hi = *(const LAS u32x2*)(rp + (((4 * s + 2 + (g >> 1)) ^ c) << 4));
                const u32x4 wv = (u32x4){lo.x, lo.y, hi.x, hi.y}; o = MFMA16(__builtin_bit_cast(bf16x8, wv), Pa[s], o); }
            o = o * inv; u32x2 w0; w0.x = cvt_pk_bf16(o[0], o[1]); w0.y = cvt_pk_bf16(o[2], o[3]);
            *(u32x2*)(O + qrow * D + h * HD + (t - 4) * 64 + db * 16 + 4 * g) = w0;
        }
    }
}
__device__ __forceinline__ void attn_sample_block(const bf16* Q, const float* K32, const float* V32, bf16* O, int pu, LAS unsigned char* lds, int tid) {
    const int lane = tid & 63, w = __builtin_amdgcn_readfirstlane(tid >> 6), c = lane & 15, g = lane >> 4, cq = c & 7;
    const int pair = 2 * pu + (w >> 2), b = pair >> 2, h = pair & 3, kq = w & 3;
    LAS float* pl = (LAS float*)(lds + w * 2048);
    LAS float* ml = (LAS float*)(lds + 16384 + w * 64);
    LAS float* ob = (LAS float*)(lds + 32768 + w * 8192);
    const size_t qrow = (size_t)MP + (size_t)b * TS + cq;
    bf16x8 Bq[8];
#pragma unroll
    for (int ks = 0; ks < 8; ++ks) Bq[ks] = *(const bf16x8*)(Q + qrow * D + h * HD + ks * 32 + 8 * g);
    f32x4 S[4];
#pragma unroll
    for (int kb = 0; kb < 4; ++kb) S[kb] = (f32x4){0.f, 0.f, 0.f, 0.f};
    const float* Kp = K32 + (((size_t)b * NMEM + kq * 64 + c) * NH + h) * HD + 8 * g;
#pragma unroll
    for (int kb = 0; kb < 4; ++kb)
#pragma unroll
        for (int ks = 0; ks < 8; ++ks) { const float* kp = Kp + (size_t)kb * 16 * NH * HD + ks * 32; const f32x4 k0 = *(const f32x4*)kp, k1 = *(const f32x4*)(kp + 4);
            u32x4 wv; wv.x = cvt_pk_bf16(k0[0], k0[1]); wv.y = cvt_pk_bf16(k0[2], k0[3]); wv.z = cvt_pk_bf16(k1[0], k1[1]); wv.w = cvt_pk_bf16(k1[2], k1[3]);
            S[kb] = MFMA16(__builtin_bit_cast(bf16x8, wv), Bq[ks], S[kb]); }
    float mx = -3.0e38f;
#pragma unroll
    for (int kb = 0; kb < 4; ++kb)
#pragma unroll
        for (int j = 0; j < 4; ++j) mx = fmaxf(mx, S[kb][j]);
    mx = fmaxf(mx, __shfl_xor(mx, 16)); mx = fmaxf(mx, __shfl_xor(mx, 32));
    float sm = 0.f;
#pragma unroll
    for (int kb = 0; kb < 4; ++kb)
#pragma unroll
        for (int j = 0; j < 4; ++j) { const float p = __builtin_amdgcn_exp2f((S[kb][j] - mx) * 1.44269504089f); S[kb][j] = p; sm += p; }
    sm += __shfl_xor(sm, 16); sm += __shfl_xor(sm, 32);
    if (c < 8) {
#pragma unroll
        for (int kb = 0; kb < 4; ++kb)
#pragma unroll
            for (int j = 0; j < 4; ++j) pl[(kb * 16 + 4 * g + j) * 8 + c] = S[kb][j];
        if (g == 0) { ml[c] = mx; ml[8 + c] = sm; }
    }
    LDS_WAIT();
    const float* Vp = V32 + (((size_t)b * NMEM + kq * 64) * NH + h) * HD + 4 * lane;
    f32x4 o[8];
#pragma unroll
    for (int q = 0; q < 8; ++q) o[q] = (f32x4){0.f, 0.f, 0.f, 0.f};
#pragma unroll 16
    for (int key = 0; key < 64; ++key) {
        const f32x4 v = *(const f32x4*)(Vp + (size_t)key * NH * HD);
        const f32x4 pa = *(const LAS f32x4*)(pl + key * 8), pb = *(const LAS f32x4*)(pl + key * 8 + 4);
        o[0] += v * pa.x; o[1] += v * pa.y; o[2] += v * pa.z; o[3] += v * pa.w; o[4] += v * pb.x; o[5] += v * pb.y; o[6] += v * pb.z; o[7] += v * pb.w;
    }
#pragma unroll
    for (int q = 0; q < 8; ++q) *(LAS f32x4*)(ob + q * 256 + 4 * lane) = o[q];
    ATT_BAR();
    const int w0 = w & 4;
#pragma unroll
    for (int qq = 0; qq < 2; ++qq) {
        const int q = 2 * kq + qq; float mi[4], li[4], mm = -3.0e38f;
#pragma unroll
        for (int i = 0; i < 4; ++i) { const LAS float* mli = (const LAS float*)(lds + 16384 + (w0 + i) * 64); mi[i] = mli[q]; li[i] = mli[8 + q]; mm = fmaxf(mm, mi[i]); }
        float L = 0.f; f32x4 acc = (f32x4){0.f, 0.f, 0.f, 0.f};
#pragma unroll
        for (int i = 0; i < 4; ++i) { const float f = __builtin_amdgcn_exp2f((mi[i] - mm) * 1.44269504089f); L += f * li[i];
            acc += *(const LAS f32x4*)((const LAS float*)(lds + 32768 + (w0 + i) * 8192) + q * 256 + 4 * lane) * f; }
        acc = acc * (1.0f / L); u32x2 wv; wv.x = cvt_pk_bf16(acc[0], acc[1]); wv.y = cvt_pk_bf16(acc[2], acc[3]);
        *(u32x2*)(O + ((size_t)MP + (size_t)b * TS + q) * D + h * HD + 4 * lane) = wv;
    }
    ATT_BAR();
}

__device__ __forceinline__ void final_row(float* xrow, const float* gf, int lane) {
    f32x4* xr = (f32x4*)xrow + lane; const f32x4* gr = (const f32x4*)gf + lane;
    f32x4 v[4]; float s = 0.f;
#pragma unroll
    for (int j = 0; j < 4; ++j) { v[j] = xr[64 * j]; s += (v[j].x * v[j].x + v[j].y * v[j].y) + (v[j].z * v[j].z + v[j].w * v[j].w); }
    s = wave_sum(s); const float rs = rsqrtf(s * (1.0f / D) + EPS);
#pragma unroll
    for (int j = 0; j < 4; ++j) xr[64 * j] = v[j] * rs * gr[64 * j];
}

__device__ __forceinline__ int opaque_lane() { int t = threadIdx.x; asm volatile("" : "+v"(t)); return t & 63; }
__global__ void __launch_bounds__(NTHREADS, 2) fwd_megakernel(Args A) {
    extern __shared__ __attribute__((aligned(16))) unsigned char lds_raw[];
    Ctx C; C.tid = threadIdx.x; C.lane = C.tid & 63; C.wave = __builtin_amdgcn_readfirstlane(C.tid >> 6); C.G = gridDim.x;
    C.gw = blockIdx.x * NWAVES + C.wave; C.NGW = C.G * NWAVES; C.lds = (LAS unsigned char*)lds_raw;
    unsigned char* ws = A.ws;
    const int bid = blockIdx.x;
    volatile LAS unsigned* MISC = (volatile LAS unsigned*)(C.lds + LDS_MISC_OFF);
    if (C.tid < 32) MISC[C.tid] = 0u;
    __syncthreads();
    const XcdBarrier xbar = xcd_barrier_post((unsigned*)(ws + WS_CTL) + CW_BAR, MISC + 8);
#define GRID_SYNC() xcd_barrier(xbar)
    bf16* XB0 = (bf16*)(ws + WS_XB0); bf16* XB1 = (bf16*)(ws + WS_XB1); bf16* XB2 = (bf16*)(ws + WS_XB2); bf16* XB3 = (bf16*)(ws + WS_XB3);
    bf16* ACT = (bf16*)(ws + WS_ACT); bf16* ZB = (bf16*)(ws + WS_Z); bf16* A4 = (bf16*)(ws + WS_A4); bf16* QB = (bf16*)(ws + WS_QB); bf16* OB = (bf16*)(ws + WS_OB);
    float* SSQ0 = (float*)(ws + WS_SSQ); float* SSQ1 = (float*)(ws + WS_SSQ + SSQ_STRIDE); float* SSQ2 = (float*)(ws + WS_SSQ + 2 * SSQ_STRIDE); float* SSQ3 = (float*)(ws + WS_SSQ + 3 * SSQ_STRIDE);
    float* SSQM = (float*)(ws + WS_SSQ + 4 * SSQ_STRIDE);
    float* XRES = A.out + OUT_Y;

    if (PHM & 1) p0_prologue(C, A);
    GRID_SYNC();
    if (PHM & 2) { pg8::Gemm g{XB0, (const bf16*)(ws + WS_W1IN), M, 2 * FF, D}; pg8::StaticOrder S; S.init(M, 2 * FF, C.G, bid); EpiSwiGLU E{ACT, SSQ0};
      pg8::gemm_phase<EpiSwiGLU, pg8::StaticOrder>(C.lds, g, S, E); }
    GRID_SYNC();
    if (PHM & 4) { pg8::Gemm g{ACT, (const bf16*)(ws + WS_W1OUT), M, D, FF}; pg8::StaticOrder S; S.init(M, D, C.G, bid); EpiRes E{A.in[0], A.in[1], XRES, XB1, SSQ1, 0.5f};
      pg8::gemm_phase<EpiRes, pg8::StaticOrder>(C.lds, g, S, E); }
    if (PHM & 8) { pg8::Gemm g{(const bf16*)(ws + WS_MEMN), (const bf16*)(ws + WS_WXKV), MMEM, 2 * D, D}; pg8::StaticOrder S; S.init(MMEM, 2 * D, C.G, (bid + 64) % C.G);
      EpiKV E{A.out + OUT_K_P, A.out + OUT_V_P, (bf16*)(ws + WS_KB), (bf16*)(ws + WS_VT), SSQM};
      pg8::gemm_phase<EpiKV, pg8::StaticOrder>(C.lds, g, S, E); }
    GRID_SYNC();
    if (PHM & 16) { pg8::Gemm g{XB1, (const bf16*)(ws + WS_WMIX), M, NZ, D}; pg8::StaticOrder S; S.init(M, NZ, C.G, bid); EpiScaleBf16 E{ZB, NZ, SSQ1, 1.0f};
      pg8::gemm_phase<EpiScaleBf16, pg8::StaticOrder>(C.lds, g, S, E); }
    GRID_SYNC();
    if (PHM & 32) { const int ln = opaque_lane(); for (int r = C.gw; r < M; r += C.NGW) { if (r < MP) mix_row_prompt(A, r, ln); else mix_row(A, r, ln); } }
    GRID_SYNC();
    if (PHM & 64) { pg8::Gemm g{A4, (const bf16*)(ws + WS_WEFF), M, D, D}; pg8::StaticOrder S; S.init(M, D, C.G, bid); EpiRes E{XRES, XRES + (size_t)MP * D, XRES, XB2, SSQ2, 1.0f};
      pg8::gemm_phase<EpiRes, pg8::StaticOrder>(C.lds, g, S, E); }
    GRID_SYNC();
    if (PHM & 128) { pg8::Gemm g{XB2, (const bf16*)(ws + WS_WXQ), M, D, D}; pg8::StaticOrder S; S.init(M, D, C.G, bid); EpiScaleBf16 E{QB, D, SSQ2, 1.0f};
      pg8::gemm_phase<EpiScaleBf16, pg8::StaticOrder>(C.lds, g, S, E); }
    GRID_SYNC();
    if (PHM & 256) { int tid6 = threadIdx.x; asm volatile("" : "+v"(tid6));
      for (int pu = bid; pu < NBS * NH / 2; pu += C.G) attn_sample_block(QB, A.in[5], A.in[6], OB, pu, C.lds, tid6);
      for (int u = bid; u < NBP * NH * (SEQ / 128); u += C.G) { const int bh = u >> 4, qt = u & 15; attn_prompt_block(QB, (const bf16*)(ws + WS_KB), (const bf16*)(ws + WS_VT), OB, bh >> 2, bh & 3, qt, C.lds, tid6); } }
    GRID_SYNC();
    if (PHM & 512) { pg8::Gemm g{OB, (const bf16*)(ws + WS_WXO), M, D, D}; pg8::StaticOrder S; S.init(M, D, C.G, bid); EpiRes E{XRES, XRES + (size_t)MP * D, XRES, XB3, SSQ3, 1.0f};
      pg8::gemm_phase<EpiRes, pg8::StaticOrder>(C.lds, g, S, E); }
    GRID_SYNC();
    if (PHM & 1024) { pg8::Gemm g{XB3, (const bf16*)(ws + WS_W2IN), M, 2 * FF, D}; pg8::StaticOrder S; S.init(M, 2 * FF, C.G, bid); EpiSwiGLU E{ACT, SSQ3};
      pg8::gemm_phase<EpiSwiGLU, pg8::StaticOrder>(C.lds, g, S, E); }
    GRID_SYNC();
    if (PHM & 2048) { pg8::Gemm g{ACT, (const bf16*)(ws + WS_W2OUT), M, D, FF}; pg8::StaticOrder S; S.init(M, D, C.G, bid); EpiRes E{XRES, XRES + (size_t)MP * D, XRES, nullptr, nullptr, 0.5f};
      pg8::gemm_phase<EpiRes, pg8::StaticOrder>(C.lds, g, S, E); }
    GRID_SYNC();
    if (PHM & 4096) { const int ln = opaque_lane(); for (int r = C.gw; r < M; r += C.NGW) final_row(XRES + (size_t)r * D, A.in[25], ln); }
}

extern "C" void kernel_launch(void* const* d_in, const int* in_sizes, int n_in, void* d_out, int out_size, void* d_ws, size_t ws_size, hipStream_t stream) {
    static int grid_blocks = 0;
    if (grid_blocks == 0) {
        if (n_in != 26 || (size_t)out_size != OUT_TOTAL || ws_size < WS_END) { fprintf(stderr, "kernel_launch: unexpected shapes (n_in %d, out %d, ws %zu)\n", n_in, out_size, ws_size); grid_blocks = -1; return; }
        int dev = 0, cus = 0, per_cu = 0;
        hipGetDevice(&dev);
        hipDeviceGetAttribute(&cus, hipDeviceAttributeMultiprocessorCount, dev);
        hipFuncSetAttribute((const void*)fwd_megakernel, hipFuncAttributeMaxDynamicSharedMemorySize, LDS_BYTES);
        hipOccupancyMaxActiveBlocksPerMultiprocessor(&per_cu, (const void*)fwd_megakernel, NTHREADS, LDS_BYTES);
        if (per_cu < 1) { fprintf(stderr, "kernel_launch: occupancy query says %d blocks per CU\n", per_cu); per_cu = 1; }
        (void)hipGetLastError();
        grid_blocks = cus * per_cu;
    }
    if (grid_blocks < 0) return;
    Args a{};
    for (int i = 0; i < 26; ++i) a.in[i] = (const float*)d_in[i];
    a.out = (float*)d_out; a.ws = (unsigned char*)d_ws;
    if (hipMemsetAsync((char*)d_ws + WS_CTL, 0, 1 * MiB, stream) != hipSuccess) { fprintf(stderr, "kernel_launch: memset failed\n"); return; }
    void* args[] = {&a};
    hipError_t e = hipLaunchCooperativeKernel((const void*)fwd_megakernel, dim3(grid_blocks), dim3(NTHREADS), args, LDS_BYTES, stream);
    if (e != hipSuccess) fprintf(stderr, "cooperative launch failed: %s (grid %d)\n", hipGetErrorString(e), grid_blocks);
}
```
